# Optimizing an MI355X kernel written in HIP

```python
import jax, jax.numpy as jnp
from jax import lax
import numpy as np

D_MODEL = 1024
BATCH = 32
SEQ = 2048
DEPTH = 2
DEC_BATCH = 8
DEC_SEQ = 32
PAST_LEN = 4096

CHUNK = 64
Q_BLOCK = 128
D_PLE = 256
D_CONV = D_MODEL // 2
CONV_W = 3
V_DIM = 64
QK_NOPE = 64
QK_ROPE = 32
QK_DIM = QK_NOPE + QK_ROPE
N_HEADS = (D_MODEL // 2) // V_DIM
D_ATTN = N_HEADS * V_DIM
Q_LORA = 12 * V_DIM
KV_LORA = 4 * V_DIM
D_MIX = D_CONV + D_ATTN
D_FF = -(-8 * D_MODEL // (3 * 256)) * 256
ROPE_THETA = 10000.0
EPS = 1e-6
SCALE = QK_DIM ** -0.5

OFF_B = 0
OFF_C = OFF_B + D_CONV
OFF_X = OFF_C + D_CONV
OFF_Q = OFF_X + D_CONV
OFF_KV = OFF_Q + Q_LORA
OFF_KR = OFF_KV + KV_LORA
IN_COLS = OFF_KR + QK_ROPE

kernel_name = "hymba_conv_mla_streaming_step"


def rms_norm(x, g):
    xf = x.astype(jnp.float32)
    y = xf * lax.rsqrt(jnp.mean(xf * xf, axis=-1, keepdims=True) + EPS)
    return (y * g.astype(jnp.float32)).astype(x.dtype)


def apply_rope(x, pos):
    half = x.shape[-1] // 2
    inv = ROPE_THETA ** (-jnp.arange(half, dtype=jnp.float32) / half)
    ang = pos.astype(jnp.float32)[:, None] * inv[None, :]
    ang = ang.reshape(ang.shape[:1] + (1,) * (x.ndim - 3) + (half,))
    cos, sin = jnp.cos(ang), jnp.sin(ang)
    xf = x.astype(jnp.float32)
    x1, x2 = xf[..., :half], xf[..., half:]
    return jnp.concatenate([x1 * cos - x2 * sin, x1 * sin + x2 * cos], axis=-1).astype(x.dtype)


def attend(q_nope, q_rope, k_nope, k_rope, v, mask):
    s = (jnp.einsum('nqhd,nkhd->nhqk', q_nope, k_nope)
         + jnp.einsum('nqhr,nkr->nhqk', q_rope, k_rope)).astype(jnp.float32) * SCALE
    if mask is not None:
        s = jnp.where(mask, s, jnp.finfo(jnp.float32).min)
    pr = jax.nn.softmax(s, axis=-1).astype(v.dtype)
    return jnp.einsum('nhqk,nkhd->nqhd', pr, v)


def prompt_attention(q_nope, q_rope, k_nope, k_rope, v):
    n, s = q_nope.shape[0], q_nope.shape[1]
    nb = s // Q_BLOCK
    qn = q_nope.reshape(n, nb, Q_BLOCK, N_HEADS, QK_NOPE).transpose(1, 0, 2, 3, 4)
    qr = q_rope.reshape(n, nb, Q_BLOCK, N_HEADS, QK_ROPE).transpose(1, 0, 2, 3, 4)
    key_chunk = jnp.arange(s) // CHUNK

    def block(args):
        qn_b, qr_b, bi = args
        q_chunk = (bi * Q_BLOCK + jnp.arange(Q_BLOCK)) // CHUNK
        mask = key_chunk[None, :] <= q_chunk[:, None]
        return attend(qn_b, qr_b, k_nope, k_rope, v, mask)

    out = lax.map(block, (qn, qr, jnp.arange(nb)))
    return out.transpose(1, 0, 2, 3, 4).reshape(n, s, N_HEADS, V_DIM)


def layer(x, p_i, pos, conv_prev, past_c, past_kr, w):
    (g_mix_pre, w_in, w_conv, g_q, w_uq, g_kv, w_ukv, g_conv_out, g_attn_out, w_o,
     g_mix_post, g_ffn_pre, w_gate, w_up, w_down, g_ffn_post, w_ple_proj, w_ple_gate) = w
    n, l, _ = x.shape
    h = rms_norm(x, g_mix_pre)
    z = h @ w_in
    gb = z[..., OFF_B:OFF_C]
    gc = z[..., OFF_C:OFF_X]
    xin = z[..., OFF_X:OFF_Q]
    cq = z[..., OFF_Q:OFF_KV]
    ckv_raw = z[..., OFF_KV:OFF_KR]
    kr_raw = z[..., OFF_KR:IN_COLS]

    u = gc * xin
    ext = jnp.concatenate([conv_prev.astype(u.dtype), u], axis=1)
    conv = ext[:, 0:l] * w_conv[0]
    for j in range(1, CONV_W):
        conv = conv + ext[:, j:j + l] * w_conv[j]
    conv_out = gb * conv
    new_conv = ext[:, l:]

    q = (rms_norm(cq, g_q) @ w_uq).reshape(n, l, N_HEADS, QK_DIM)
    q_nope = q[..., :QK_NOPE]
    q_rope = apply_rope(q[..., QK_NOPE:], pos)
    c_kv = rms_norm(ckv_raw, g_kv)
    k_rope = apply_rope(kr_raw, pos)
    if past_c is None:
        kv = (c_kv @ w_ukv).reshape(n, l, N_HEADS, QK_NOPE + V_DIM)
        attn = prompt_attention(q_nope, q_rope, kv[..., :QK_NOPE], k_rope, kv[..., QK_NOPE:])
    else:
        c_all = jnp.concatenate([past_c.astype(c_kv.dtype), c_kv], axis=1)
        kr_all = jnp.concatenate([past_kr.astype(k_rope.dtype), k_rope], axis=1)
        kv = (c_all @ w_ukv).reshape(n, c_all.shape[1], N_HEADS, QK_NOPE + V_DIM)
        attn = attend(q_nope, q_rope, kv[..., :QK_NOPE], kr_all, kv[..., QK_NOPE:], None)
    attn = attn.reshape(n, l, D_ATTN)

    mix = jnp.concatenate([rms_norm(conv_out, g_conv_out), rms_norm(attn, g_attn_out)], axis=-1) @ w_o
    x = x + rms_norm(mix, g_mix_post)

    h = rms_norm(x, g_ffn_pre)
    f = (jax.nn.silu(h @ w_gate) * (h @ w_up)) @ w_down
    x = x + rms_norm(f, g_ffn_post)

    x = x + jax.nn.sigmoid(x @ w_ple_gate) * (p_i @ w_ple_proj)
    return x, c_kv, k_rope, new_conv


def setup_inputs(seed: int = 0) -> dict:
    key = jax.random.key(seed)
    ks = iter(jax.random.split(key, 40))

    def nrm(shape, scale=1.0):
        return jax.random.normal(next(ks), shape, jnp.float32) * scale

    def gain(shape):
        return 1.0 + 0.05 * nrm(shape)

    return {
        "x_prompt": nrm((BATCH, SEQ, D_MODEL)),
        "x_sample": nrm((DEC_BATCH, DEC_SEQ, D_MODEL)),
        "cache_kv_latent": nrm((DEPTH, DEC_BATCH, PAST_LEN, KV_LORA)),
        "cache_k_rope": nrm((DEPTH, DEC_BATCH, PAST_LEN, QK_ROPE)),
        "state_conv": nrm((DEPTH, DEC_BATCH, CONV_W - 1, D_CONV)),
        "p_prompt": nrm((DEPTH, BATCH, SEQ, D_PLE)),
        "p_sample": nrm((DEPTH, DEC_BATCH, DEC_SEQ, D_PLE)),
        "g_mix_pre": gain((DEPTH, D_MODEL)),
        "w_in": nrm((DEPTH, D_MODEL, IN_COLS), D_MODEL ** -0.5),
        "w_conv": nrm((DEPTH, CONV_W, D_CONV), CONV_W ** -0.5),
        "g_q": gain((DEPTH, Q_LORA)),
        "w_uq": nrm((DEPTH, Q_LORA, N_HEADS * QK_DIM), Q_LORA ** -0.5),
        "g_kv": gain((DEPTH, KV_LORA)),
        "w_ukv": nrm((DEPTH, KV_LORA, N_HEADS * (QK_NOPE + V_DIM)), KV_LORA ** -0.5),
        "g_conv_out": gain((DEPTH, D_CONV)),
        "g_attn_out": gain((DEPTH, D_ATTN)),
        "w_o": nrm((DEPTH, D_MIX, D_MODEL), D_MIX ** -0.5),
        "g_mix_post": gain((DEPTH, D_MODEL)),
        "g_ffn_pre": gain((DEPTH, D_MODEL)),
        "w_ffn_gate": nrm((DEPTH, D_MODEL, D_FF), D_MODEL ** -0.5),
        "w_ffn_up": nrm((DEPTH, D_MODEL, D_FF), D_MODEL ** -0.5),
        "w_ffn_down": nrm((DEPTH, D_FF, D_MODEL), D_FF ** -0.5),
        "g_ffn_post": gain((DEPTH, D_MODEL)),
        "w_ple_proj": nrm((DEPTH, D_PLE, D_MODEL), D_PLE ** -0.5),
        "w_ple_gate": nrm((DEPTH, D_MODEL, D_MODEL), D_MODEL ** -0.5),
    }


def reference(x_prompt, x_sample, cache_kv_latent, cache_k_rope, state_conv, p_prompt, p_sample,
              g_mix_pre, w_in, w_conv, g_q, w_uq, g_kv, w_ukv, g_conv_out, g_attn_out, w_o,
              g_mix_post, g_ffn_pre, w_ffn_gate, w_ffn_up, w_ffn_down, g_ffn_post,
              w_ple_proj, w_ple_gate):
    n_p, s_p = x_prompt.shape[0], x_prompt.shape[1]
    s_d = x_sample.shape[1]
    past_len = cache_kv_latent.shape[2]
    pos_p = jnp.arange(s_p)
    pos_d = past_len + jnp.arange(s_d)
    conv_zero = jnp.zeros((n_p, CONV_W - 1, D_CONV), x_prompt.dtype)

    xp, xd = x_prompt, x_sample
    lat_p, kr_p, cv_p, lat_d, kr_d, cv_d = [], [], [], [], [], []
    for i in range(DEPTH):
        w = (g_mix_pre[i], w_in[i], w_conv[i], g_q[i], w_uq[i], g_kv[i], w_ukv[i],
             g_conv_out[i], g_attn_out[i], w_o[i], g_mix_post[i], g_ffn_pre[i],
             w_ffn_gate[i], w_ffn_up[i], w_ffn_down[i], g_ffn_post[i],
             w_ple_proj[i], w_ple_gate[i])
        xp, c_p, k_p, s_p_new = layer(xp, p_prompt[i], pos_p, conv_zero, None, None, w)
        xd, c_d, k_d, s_d_new = layer(xd, p_sample[i], pos_d, state_conv[i],
                                      cache_kv_latent[i], cache_k_rope[i], w)
        lat_p.append(c_p); kr_p.append(k_p); cv_p.append(s_p_new)
        lat_d.append(c_d); kr_d.append(k_d); cv_d.append(s_d_new)

    new_kv_latent_prompt = jnp.stack(lat_p)
    new_k_rope_prompt = jnp.stack(kr_p)
    new_conv_prompt = jnp.stack(cv_p)
    new_kv_latent_sample = jnp.stack(lat_d)
    new_k_rope_sample = jnp.stack(kr_d)
    new_conv_sample = jnp.stack(cv_d)
    return (xp, xd, new_kv_latent_prompt, new_k_rope_prompt, new_conv_prompt,
            new_kv_latent_sample, new_k_rope_sample, new_conv_sample)
```

```cpp
#include <hip/hip_runtime.h>
#include <hip/hip_cooperative_groups.h>
#include <cstdio>
#include <cstdint>
namespace cg = cooperative_groups;
namespace pg8 {
#define PG8_LAS __attribute__((address_space(3)))
typedef unsigned short bf16_t;
typedef short bf16x8 __attribute__((ext_vector_type(8)));
typedef float f32x4 __attribute__((ext_vector_type(4)));
typedef unsigned u32x4 __attribute__((ext_vector_type(4)));
constexpr int BM = 256, BK = 64, HALF = 128, HTB = HALF * BK * 2  , STAGE_BYTES = 8 * HTB, NXCD = 8, WGM = 8;

__host__ __device__ __forceinline__ int lds_byte(int r, int c) { const int st = (r >> 4) * 2 + (c >> 5), rr = r & 15, cc = c & 31, ob = rr * 64 + cc * 2; return st * 1024 + (ob ^ (((ob >> 9) & 1) << 5)); }
__host__ __device__ __forceinline__ void stage_rc(int b, int& R, int& C) { const int st = b / 1024, sb = b % 1024, swz = sb ^ (((sb >> 9) & 1) << 5); R = (st >> 1) * 16 + swz / 64; C = (st & 1) * 32 + (swz % 64) / 2; }
__host__ __device__ __forceinline__ int perm32(int rho) { const int n = rho >> 4, i = rho & 15; return 8 * (i >> 2) + 4 * n + (i & 3); }

struct Unit { int pm, pn; };
struct Gemm { const bf16_t* A; const bf16_t* Bt; int M, N, K; };

struct StaticOrder {
    int nM, nN, nwg, G, c;
    __host__ __device__ void init(int M, int N, int G_, int c_) { nM = M / BM; nN = N / BM; nwg = nM * nN; G = G_; c = c_; }
    __host__ __device__ bool next(int i, Unit& u) const {
        const long L = (long)i * G + c; if (L >= nwg) return false;
        int wgid = (int)L; { const int q = nwg / NXCD, r = nwg % NXCD, xcd = wgid % NXCD, off = wgid / NXCD; wgid = (xcd < r ? xcd * (q + 1) : r * (q + 1) + (xcd - r) * q) + off; }
        const int nig = WGM * nN, gid = wgid / nig, fm = gid * WGM, gsz = (nM - fm) < WGM ? (nM - fm) : WGM;
        u.pm = fm + ((wgid % nig) % gsz); u.pn = (wgid % nig) / gsz; return true;
    }
    __device__ __forceinline__ void a_ready(const Unit&) const {}
    __device__ __forceinline__ void done(const Unit&) const {}
};

__device__ __forceinline__ unsigned cvt_pk_bf16(float lo, float hi) { unsigned r; asm volatile("v_cvt_pk_bf16_f32 %0, %1, %2" : "=v"(r) : "v"(lo), "v"(hi)); return r; }
typedef float f32x2 __attribute__((ext_vector_type(2)));
__device__ __forceinline__ f32x2 gelu_pk(f32x2 v) {
    const f32x2 av = __builtin_elementwise_abs(v), d = av * 0.2316418882f + 1.0f;
    f32x2 t; t.x = __builtin_amdgcn_rcpf(d.x); t.y = __builtin_amdgcn_rcpf(d.y);
    f32x2 q = t * 0.5307027145f + (-0.7265760135f); q = q * t + 0.7107068705f; q = q * t + (-0.142248368f); q = q * t + 0.127414796f; q = q * t;
    const f32x2 s = (v * v) * (-0.72134752044f);
    f32x2 e; e.x = __builtin_amdgcn_exp2f(s.x); e.y = __builtin_amdgcn_exp2f(s.y);
    const f32x2 m = v * (q * e), r = v - m;
    f32x2 o; o.x = v.x < 0.f ? m.x : r.x; o.y = v.y < 0.f ? m.y : r.y; return o;
}

template <int ACT  > struct EpiBf16 {
    static constexpr bool PERM = true, AFTER_DRAIN = false; static_assert(ACT == 0 || ACT == 1, "EpiBf16: ACT is 0 (none) or 1 (gelu_pk)");
    bf16_t* O; int ldc; const float* bias; int split_cols; size_t split_stride; float scale0;
    __device__ __forceinline__ void operator()(const f32x4 (&acc)[2][2][4][2], const Unit& u, int wr, int wc, int fr, int fq) const {
        const int row0 = u.pm * BM + wr * 64 + fr; int colt = u.pn * BM; bf16_t* base = O;
        float sc = 1.f; if (split_cols) { const int t = colt / split_cols; base += (size_t)t * split_stride; colt -= t * split_cols; if (t == 0) sc = scale0; }
        const int col0 = colt + wc * 32 + 8 * fq, bcol0 = u.pn * BM + wc * 32 + 8 * fq;
        f32x4 bv[2][2];
#pragma unroll
        for (int bj = 0; bj < 2; ++bj)
#pragma unroll
            for (int n = 0; n < 2; ++n) bv[bj][n] = bias ? *(const f32x4*)(bias + bcol0 + bj * HALF + 4 * n) : (f32x4){0.f, 0.f, 0.f, 0.f};
#pragma unroll
        for (int ai = 0; ai < 2; ++ai)
#pragma unroll
            for (int m = 0; m < 4; ++m) { bf16_t* rowp = base + (size_t)(row0 + ai * HALF + m * 16) * ldc + col0;
#pragma unroll
                for (int bj = 0; bj < 2; ++bj) { f32x4 v0 = acc[ai][bj][m][0] + bv[bj][0], v1 = acc[ai][bj][m][1] + bv[bj][1];
                    if (ACT == 1) { f32x2 a = gelu_pk((f32x2){v0[0], v0[1]}), b = gelu_pk((f32x2){v0[2], v0[3]}), c = gelu_pk((f32x2){v1[0], v1[1]}), d = gelu_pk((f32x2){v1[2], v1[3]});
                        v0 = (f32x4){a.x, a.y, b.x, b.y}; v1 = (f32x4){c.x, c.y, d.x, d.y}; }
                    v0 = v0 * sc; v1 = v1 * sc; u32x4 w; w.x = cvt_pk_bf16(v0[0], v0[1]); w.y = cvt_pk_bf16(v0[2], v0[3]); w.z = cvt_pk_bf16(v1[0], v1[1]); w.w = cvt_pk_bf16(v1[2], v1[3]);
                    *(u32x4*)(rowp + bj * HALF) = w; } }
    }
};
typedef __bf16 bf2_t __attribute__((ext_vector_type(2)));
typedef float f2_t __attribute__((ext_vector_type(2)));
__device__ __forceinline__ unsigned pkbf(float lo, float hi) { f2_t v = {lo, hi}; return __builtin_bit_cast(unsigned, __builtin_convertvector(v, bf2_t)); }
__device__ __forceinline__ float bflo(unsigned w) { return __uint_as_float(w << 16); }
__device__ __forceinline__ float bfhi(unsigned w) { return __uint_as_float(w & 0xffff0000u); }
__device__ __forceinline__ float fsigmoid(float g) { return __builtin_amdgcn_rcpf(1.0f + __builtin_amdgcn_exp2f(-1.44269504f * g)); }

struct EpiRowScale {
    static constexpr bool PERM = true, AFTER_DRAIN = false;
    bf16_t* O; int ldc; const float* ss; float invk, eps;
    __device__ __forceinline__ void operator()(const f32x4 (&acc)[2][2][4][2], const Unit& u, int wr, int wc, int fr, int fq) const {
        const int row0 = u.pm * BM + wr * 64 + fr, col0 = u.pn * BM + wc * 32 + 8 * fq;
#pragma unroll
        for (int ai = 0; ai < 2; ++ai)
#pragma unroll
            for (int m = 0; m < 4; ++m) { const int row = row0 + ai * HALF + m * 16; const float sc = rsqrtf(ss[row] * invk + eps); bf16_t* rowp = O + (size_t)row * ldc + col0;
#pragma unroll
                for (int bj = 0; bj < 2; ++bj) { const f32x4 v0 = acc[ai][bj][m][0] * sc, v1 = acc[ai][bj][m][1] * sc;
                    u32x4 w; w.x = pkbf(v0[0], v0[1]); w.y = pkbf(v0[2], v0[3]); w.z = pkbf(v1[0], v1[1]); w.w = pkbf(v1[2], v1[3]);
                    *(u32x4*)(rowp + bj * HALF) = w; } }
    }
};

struct EpiG1 {
    static constexpr bool PERM = true, AFTER_DRAIN = false;
    bf16_t* ub; bf16_t* gbb; bf16_t* Aq; bf16_t* zs; float* ssq; const float* ss; float invk, eps;
    __device__ __forceinline__ void operator()(const f32x4 (&acc)[2][2][4][2], const Unit& u, int wr, int wc, int fr, int fq) const {
        const int row0 = u.pm * BM + wr * 64 + fr, pn = u.pn, cw = wc * 32 + 8 * fq;
#pragma unroll
        for (int ai = 0; ai < 2; ++ai)
#pragma unroll
            for (int m = 0; m < 4; ++m) { const int row = row0 + ai * HALF + m * 16; const float sc = rsqrtf(ss[row] * invk + eps);
                if (pn < 4) { float h[8];
#pragma unroll
                    for (int n = 0; n < 2; ++n)
#pragma unroll
                        for (int j = 0; j < 4; ++j) h[4 * n + j] = (acc[ai][0][m][n][j] * sc) * (acc[ai][1][m][n][j] * sc);
                    u32x4 w; w.x = pkbf(h[0], h[1]); w.y = pkbf(h[2], h[3]); w.z = pkbf(h[4], h[5]); w.w = pkbf(h[6], h[7]);
                    *(u32x4*)(ub + (size_t)row * 512 + pn * HALF + cw) = w;
                } else { float ssum = 0.f;
#pragma unroll
                    for (int bj = 0; bj < 2; ++bj) { const f32x4 v0 = acc[ai][bj][m][0] * sc, v1 = acc[ai][bj][m][1] * sc;
                        u32x4 w; w.x = pkbf(v0[0], v0[1]); w.y = pkbf(v0[2], v0[3]); w.z = pkbf(v1[0], v1[1]); w.w = pkbf(v1[2], v1[3]);
                        const int c = bj * HALF + cw;
                        if (pn < 6) *(u32x4*)(gbb + (size_t)row * 512 + (pn - 4) * BM + c) = w;
                        else if (pn < 9) { *(u32x4*)(Aq + (size_t)row * 768 + (pn - 6) * BM + c) = w;
                            const float a0 = bflo(w.x), a1 = bfhi(w.x), a2 = bflo(w.y), a3 = bfhi(w.y), a4 = bflo(w.z), a5 = bfhi(w.z), a6 = bflo(w.w), a7 = bfhi(w.w);
                            ssum += (a0 * a0 + a1 * a1) + (a2 * a2 + a3 * a3) + (a4 * a4 + a5 * a5) + (a6 * a6 + a7 * a7); }
                        else if (pn == 9) *(u32x4*)(zs + (size_t)row * 320 + c) = w;
                        else if (c < 32) *(u32x4*)(zs + (size_t)row * 320 + 256 + c) = w; }
                    if (pn >= 6 && pn < 9) { ssum += __shfl_xor(ssum, 16); ssum += __shfl_xor(ssum, 32); if (fq == 0) atomicAdd(ssq + row, ssum); } } }
    }
};
struct EpiSwiGLU {
    static constexpr bool PERM = true, AFTER_DRAIN = false;
    bf16_t* O; int ldc; const float* ss; float invk, eps;
    __device__ __forceinline__ void operator()(const f32x4 (&acc)[2][2][4][2], const Unit& u, int wr, int wc, int fr, int fq) const {
        const int row0 = u.pm * BM + wr * 64 + fr, col0 = u.pn * HALF + wc * 32 + 8 * fq;
#pragma unroll
        for (int ai = 0; ai < 2; ++ai)
#pragma unroll
            for (int m = 0; m < 4; ++m) { const int row = row0 + ai * HALF + m * 16; const float sc = rsqrtf(ss[row] * invk + eps);
                float h[8];
#pragma unroll
                for (int n = 0; n < 2; ++n)
#pragma unroll
                    for (int j = 0; j < 4; ++j) { const float g = acc[ai][0][m][n][j] * sc, up = acc[ai][1][m][n][j] * sc; h[4 * n + j] = g * fsigmoid(g) * up; }
                u32x4 w; w.x = pkbf(h[0], h[1]); w.y = pkbf(h[2], h[3]); w.z = pkbf(h[4], h[5]); w.w = pkbf(h[6], h[7]);
                *(u32x4*)(O + (size_t)row * ldc + col0) = w; }
    }
};
struct EpiPle {
    static constexpr bool PERM = true, AFTER_DRAIN = false;
    const bf16_t* xin; const bf16_t* pp; bf16_t* xbn; float* Y; float* ssn; int last;
    __device__ __forceinline__ void operator()(const f32x4 (&acc)[2][2][4][2], const Unit& u, int wr, int wc, int fr, int fq) const {
        const int row0 = u.pm * BM + wr * 64 + fr, col0 = u.pn * BM + wc * 32 + 8 * fq;
#pragma unroll
        for (int ai = 0; ai < 2; ++ai)
#pragma unroll
            for (int m = 0; m < 4; ++m) { const int row = row0 + ai * HALF + m * 16; float ssum = 0.f;
#pragma unroll
                for (int bj = 0; bj < 2; ++bj) { const size_t off = (size_t)row * 1024 + col0 + bj * HALF;
                    const u32x4 xw = *(const u32x4*)(xin + off); const u32x4 pw = *(const u32x4*)(pp + off);
                    f32x4 x0 = {bflo(xw.x), bfhi(xw.x), bflo(xw.y), bfhi(xw.y)}, x1 = {bflo(xw.z), bfhi(xw.z), bflo(xw.w), bfhi(xw.w)};
                    const f32x4 p0 = {bflo(pw.x), bfhi(pw.x), bflo(pw.y), bfhi(pw.y)}, p1 = {bflo(pw.z), bfhi(pw.z), bflo(pw.w), bfhi(pw.w)};
                    const f32x4 g0 = acc[ai][bj][m][0], g1 = acc[ai][bj][m][1];
#pragma unroll
                    for (int j = 0; j < 4; ++j) { x0[j] += fsigmoid(g0[j]) * p0[j]; x1[j] += fsigmoid(g1[j]) * p1[j]; }
                    if (last) { *(f32x4*)(Y + off) = x0; *(f32x4*)(Y + off + 4) = x1; }
                    else { u32x4 w; w.x = pkbf(x0[0], x0[1]); w.y = pkbf(x0[2], x0[3]); w.z = pkbf(x1[0], x1[1]); w.w = pkbf(x1[2], x1[3]); *(u32x4*)(xbn + off) = w;
                        ssum += (x0[0] * x0[0] + x0[1] * x0[1]) + (x0[2] * x0[2] + x0[3] * x0[3]) + (x1[0] * x1[0] + x1[1] * x1[1]) + (x1[2] * x1[2] + x1[3] * x1[3]); } }
                if (!last) { ssum += __shfl_xor(ssum, 16); ssum += __shfl_xor(ssum, 32); if (fq == 0) atomicAdd(ssn + row, ssum); } }
    }
};
struct EpiQRope {
    static constexpr bool PERM = false, AFTER_DRAIN = false;
    bf16_t* O; const f2_t* tab; float qscale; const float* ssq;
    __device__ __forceinline__ void operator()(const f32x4 (&acc)[2][2][4][2], const Unit& u, int wr, int wc, int fr, int fq) const {
        typedef unsigned u32x2 __attribute__((ext_vector_type(2)));
        const int row0 = u.pm * BM + wr * 64 + fr;
#pragma unroll
        for (int ai = 0; ai < 2; ++ai)
#pragma unroll
            for (int m = 0; m < 4; ++m) { const int row = row0 + ai * HALF + m * 16; const int pos = row < 65536 ? (row & 2047) : 4096 + ((row - 65536) & 31);
#pragma unroll
                for (int bj = 0; bj < 2; ++bj) { const int c0 = u.pn * BM + bj * HALF + wc * 32; f32x4 a = acc[ai][bj][m][0], b = acc[ai][bj][m][1];
                    if ((c0 % 96) == 64) {
#pragma unroll
                        for (int j = 0; j < 4; ++j) { const f2_t cs = tab[pos * 16 + 4 * fq + j]; const float x1 = a[j], x2 = b[j]; a[j] = x1 * cs.x - x2 * cs.y; b[j] = x1 * cs.y + x2 * cs.x; } }
                    { const float qs = qscale * rsqrtf(ssq[row] * (1.0f / 768.0f) + 1e-6f); a = a * qs; b = b * qs; }
                    bf16_t* p = O + (size_t)row * 768 + c0 + 4 * fq;
                    u32x2 wa, wb; wa.x = pkbf(a[0], a[1]); wa.y = pkbf(a[2], a[3]); wb.x = pkbf(b[0], b[1]); wb.y = pkbf(b[2], b[3]);
                    *(u32x2*)p = wa; *(u32x2*)(p + 16) = wb; } }
    }
};

__host__ __device__ __forceinline__ int pi5(int k) { return (k & 0x13) | ((k & 4) << 1) | ((k & 8) >> 1); }
__host__ __device__ __forceinline__ size_t kf_off(int row, int h, int d0) { return ((((size_t)(row >> 5) * 8 + h) * 4 + (d0 >> 4)) * 64 + ((d0 >> 3) & 1) * 32 + pi5(row & 31)) * 8; }
__host__ __device__ __forceinline__ size_t vf_off(int h, int d, int kv0) { return (((((size_t)(kv0 >> 5) * 8 + h) * 2 + (d >> 5)) * 2 + ((kv0 >> 4) & 1)) * 64 + ((kv0 >> 3) & 1) * 32 + (d & 31)) * 8; }
__host__ __device__ __forceinline__ size_t krf_off(int row, int i) { return ((((size_t)(row >> 5) * 2 + (i >> 4)) * 64 + ((i >> 3) & 1) * 32 + pi5(row & 31)) * 8) + (i & 7); }
struct EpiBf16M {
    static constexpr bool PERM = true, AFTER_DRAIN = false;
    bf16_t* O; int ldc; int mode;
    __device__ __forceinline__ void operator()(const f32x4 (&acc)[2][2][4][2], const Unit& u, int wr, int wc, int fr, int fq) const {
        const int row0 = u.pm * BM + wr * 64 + fr, col0 = u.pn * BM + wc * 32 + 8 * fq;
#pragma unroll
        for (int ai = 0; ai < 2; ++ai)
#pragma unroll
            for (int m = 0; m < 4; ++m) { const int row = row0 + ai * HALF + m * 16;
#pragma unroll
                for (int bj = 0; bj < 2; ++bj) { const int col = col0 + bj * HALF; const f32x4 v0 = acc[ai][bj][m][0], v1 = acc[ai][bj][m][1];
                    u32x4 w; w.x = pkbf(v0[0], v0[1]); w.y = pkbf(v0[2], v0[3]); w.z = pkbf(v1[0], v1[1]); w.w = pkbf(v1[2], v1[3]);
                    const size_t off = mode == 0 ? (size_t)row * ldc + col : (mode == 1 ? kf_off(row, col >> 6, col & 63) : vf_off(row >> 6, row & 63, col));
                    *(u32x4*)(O + off) = w; } }
    }
};
template <class Epi, class Sched, bool ALIGN_EPI = false, bool SP2 = false>
__device__ __forceinline__ void gemm_phase(PG8_LAS unsigned char* lds, const Gemm g, const Sched& S, const Epi& E) {
    int tid_ = threadIdx.x; asm volatile("" : "+v"(tid_));
    const int tid = tid_, wid = __builtin_amdgcn_readfirstlane(tid >> 6), lane = tid & 63, wr = wid >> 2, wc = wid & 3, fr = lane & 15, fq = lane >> 4;
    const int K = g.K, nt = K / BK;
    unsigned voffA[2], voffB[2];
#pragma unroll
    for (int i = 0; i < 2; ++i) { int R, C; stage_rc(tid * 16 + i * 8192, R, C); const int Rb = Epi::PERM ? ((R & ~31) + perm32(R & 31)) : R;
        voffA[i] = (unsigned)(R * K + C) * 2u; voffB[i] = (unsigned)(Rb * K + C) * 2u; }
    const size_t kstep = (size_t)(BK * 2);
    const size_t hstep = (size_t)HALF * K * 2;
    const size_t tstep = 2 * hstep;
    const unsigned ldsw = (unsigned)wid * 1024u;
    const int aoff = lds_byte(wr * 64 + fr, fq * 8), boff = lds_byte(wc * 32 + fr, fq * 8);
#define PG8_SA(b, h) (((b) * 2 + (h)) * HTB)
#define PG8_SB(b, h) ((4 + (b) * 2 + (h)) * HTB)
#define PG8_STAGE(bufoff, gbase, voff) do { _Pragma("unroll") for (int _i = 0; _i < 2; ++_i) \
        __builtin_amdgcn_global_load_lds((const unsigned*)((const char*)(gbase) + (voff)[_i]), (PG8_LAS unsigned*)(lds + (bufoff) + ldsw + _i * 8192), 16, 0, 0); } while (0)
#define PG8_LDA(dst, b, h) do { _Pragma("unroll") for (int m = 0; m < 4; ++m) _Pragma("unroll") for (int k = 0; k < 2; ++k) dst[m][k] = *(const PG8_LAS bf16x8*)(lds + PG8_SA(b, h) + aoff + m * 2048 + k * 1024); } while (0)
#define PG8_LDB(dst, b, h) do { _Pragma("unroll") for (int n = 0; n < 2; ++n) _Pragma("unroll") for (int k = 0; k < 2; ++k) dst[n][k] = *(const PG8_LAS bf16x8*)(lds + PG8_SB(b, h) + boff + n * 2048 + k * 1024); } while (0)
#define PG8_MMA(ai, bj, At, Bt) do { __builtin_amdgcn_s_setprio(1); _Pragma("unroll") for (int m = 0; m < 4; ++m) _Pragma("unroll") for (int n = 0; n < 2; ++n) _Pragma("unroll") for (int k = 0; k < 2; ++k) \
        acc[ai][bj][m][n] = __builtin_amdgcn_mfma_f32_16x16x32_bf16(Bt[n][k], At[m][k], acc[ai][bj][m][n], 0, 0, 0); __builtin_amdgcn_s_setprio(0); } while (0)
#define PG8_WAIT_V(n) asm volatile("s_waitcnt vmcnt(" #n ")" ::: "memory")
#define PG8_WAIT_L(n) asm volatile("s_waitcnt lgkmcnt(" #n ")" ::: "memory")
#define PG8_BAR __builtin_amdgcn_s_barrier()
#define PG8_SCHED __builtin_amdgcn_sched_barrier(0)
    Unit cur, nxt; int ui = 0;
    if (!S.next(0, cur)) return;
    f32x4 acc[2][2][4][2];
#pragma unroll
    for (int a = 0; a < 2; ++a)
#pragma unroll
        for (int b = 0; b < 2; ++b)
#pragma unroll
            for (int m = 0; m < 4; ++m)
#pragma unroll
                for (int n = 0; n < 2; ++n) acc[a][b][m][n] = (f32x4){0.f, 0.f, 0.f, 0.f};
    bf16x8 At[4][2], B0[2][2], B1[2][2];
    const char* cA = (const char*)g.A + (size_t)cur.pm * tstep; const char* cB = (const char*)g.Bt + (size_t)cur.pn * tstep;
    S.a_ready(cur);
    if constexpr (SP2) {
        PG8_STAGE(PG8_SB(0, 0), cB, voffB); PG8_STAGE(PG8_SB(0, 1), cB + hstep, voffB); PG8_STAGE(PG8_SA(0, 0), cA, voffA); PG8_STAGE(PG8_SA(0, 1), cA + hstep, voffA);
        if (wr == 1) PG8_BAR;
        PG8_WAIT_V(2); PG8_BAR;
        PG8_STAGE(PG8_SB(1, 0), cB + kstep, voffB); PG8_STAGE(PG8_SA(1, 0), cA + kstep, voffA); PG8_STAGE(PG8_SB(1, 1), cB + hstep + kstep, voffB);
        PG8_WAIT_V(6); PG8_BAR;
    } else {
        PG8_STAGE(PG8_SB(0, 0), cB, voffB); PG8_STAGE(PG8_SA(0, 0), cA, voffA); PG8_STAGE(PG8_SB(0, 1), cB + hstep, voffB); PG8_STAGE(PG8_SA(0, 1), cA + hstep, voffA);
        if (wr == 1) PG8_BAR;
        PG8_WAIT_V(4); PG8_BAR;
        PG8_STAGE(PG8_SB(1, 0), cB + kstep, voffB); PG8_STAGE(PG8_SA(1, 0), cA + kstep, voffA); PG8_STAGE(PG8_SB(1, 1), cB + hstep + kstep, voffB);
        PG8_WAIT_V(6); PG8_BAR;
    }
    for (;;) {
        const bool has_next = S.next(ui + 1, nxt);
        const char* nA = has_next ? (const char*)g.A + (size_t)nxt.pm * tstep : cA; const char* nB = has_next ? (const char*)g.Bt + (size_t)nxt.pn * tstep : cB;
        for (int t = 0; t < nt; t += 2) {
            const bool last = (t == nt - 2);
            const char* a1 = cA + (size_t)(t + 1) * kstep;
            const char* a2 = last ? nA : cA + (size_t)(t + 2) * kstep; const char* b2 = last ? nB : cB + (size_t)(t + 2) * kstep;
            const char* a3 = a2 + kstep; const char* b3 = b2 + kstep;
            if (last && has_next) S.a_ready(nxt);
            if constexpr (SP2) {
            PG8_LDB(B0, 0, 0); PG8_LDB(B1, 0, 1); PG8_SCHED; PG8_LDA(At, 0, 0); PG8_STAGE(PG8_SA(1, 1), a1 + hstep, voffA);
            PG8_WAIT_V(8); PG8_WAIT_L(0); PG8_BAR; PG8_MMA(0, 0, At, B0); PG8_MMA(0, 1, At, B1); PG8_BAR; PG8_SCHED;
            PG8_LDA(At, 0, 1); PG8_STAGE(PG8_SB(0, 0), b2, voffB); PG8_STAGE(PG8_SB(0, 1), b2 + hstep, voffB); PG8_STAGE(PG8_SA(0, 0), a2, voffA);
            PG8_WAIT_V(8); PG8_WAIT_L(0); PG8_BAR; PG8_MMA(1, 0, At, B0); PG8_MMA(1, 1, At, B1); PG8_BAR; PG8_SCHED;
            PG8_LDB(B0, 1, 0); PG8_LDB(B1, 1, 1); PG8_SCHED; PG8_LDA(At, 1, 0); PG8_STAGE(PG8_SA(0, 1), a2 + hstep, voffA);
            PG8_WAIT_V(8); PG8_WAIT_L(0); PG8_BAR; PG8_MMA(0, 0, At, B0); PG8_MMA(0, 1, At, B1); PG8_BAR; PG8_SCHED;
            PG8_LDA(At, 1, 1); PG8_STAGE(PG8_SB(1, 0), b3, voffB); PG8_STAGE(PG8_SB(1, 1), b3 + hstep, voffB); PG8_STAGE(PG8_SA(1, 0), a3, voffA);
            PG8_WAIT_V(8); PG8_WAIT_L(0); PG8_BAR; PG8_MMA(1, 0, At, B0); PG8_MMA(1, 1, At, B1); PG8_BAR; PG8_SCHED;
            } else {
            PG8_LDB(B0, 0, 0); PG8_SCHED; PG8_LDA(At, 0, 0); PG8_STAGE(PG8_SA(1, 1), a1 + hstep, voffA);
            PG8_WAIT_L(8); PG8_BAR; PG8_WAIT_L(0); PG8_MMA(0, 0, At, B0); PG8_BAR; PG8_SCHED;
            PG8_LDB(B1, 0, 1); PG8_STAGE(PG8_SB(0, 0), b2, voffB);
            PG8_BAR; PG8_WAIT_L(0); PG8_MMA(0, 1, At, B1); PG8_BAR;
            PG8_LDA(At, 0, 1); PG8_STAGE(PG8_SA(0, 0), a2, voffA);
            PG8_BAR; PG8_WAIT_L(0); PG8_MMA(1, 0, At, B0); PG8_BAR; PG8_SCHED;
            PG8_STAGE(PG8_SB(0, 1), b2 + hstep, voffB);
            PG8_WAIT_V(6); PG8_BAR; PG8_MMA(1, 1, At, B1); PG8_BAR;
            PG8_LDB(B0, 1, 0); PG8_SCHED; PG8_LDA(At, 1, 0); PG8_STAGE(PG8_SA(0, 1), a2 + hstep, voffA);
            PG8_WAIT_L(8); PG8_BAR; PG8_WAIT_L(0); PG8_MMA(0, 0, At, B0); PG8_BAR; PG8_SCHED;
            PG8_LDB(B1, 1, 1); PG8_STAGE(PG8_SB(1, 0), b3, voffB);
            PG8_BAR; PG8_WAIT_L(0); PG8_MMA(0, 1, At, B1); PG8_BAR;
            PG8_LDA(At, 1, 1); PG8_STAGE(PG8_SA(1, 0), a3, voffA);
            PG8_BAR; PG8_WAIT_L(0); PG8_MMA(1, 0, At, B0); PG8_BAR; PG8_SCHED;
            PG8_STAGE(PG8_SB(1, 1), b3 + hstep, voffB);
            PG8_WAIT_V(6); PG8_BAR; PG8_MMA(1, 1, At, B1); PG8_BAR;
            }
        }
        if constexpr (ALIGN_EPI) { if (wr == 0) PG8_BAR; }
        if constexpr (!Epi::AFTER_DRAIN) { E(acc, cur, wr, wc, fr, fq); S.done(cur); }
        if (!has_next) break;
#pragma unroll
        for (int a = 0; a < 2; ++a)
#pragma unroll
            for (int b = 0; b < 2; ++b)
#pragma unroll
                for (int m = 0; m < 4; ++m)
#pragma unroll
                    for (int n = 0; n < 2; ++n) acc[a][b][m][n] = (f32x4){0.f, 0.f, 0.f, 0.f};
        cur = nxt; cA = nA; cB = nB; ++ui;
        if constexpr (ALIGN_EPI) { if (wr == 1) PG8_BAR; }
    }
    PG8_WAIT_V(0);
    if constexpr (!ALIGN_EPI) { if (wr == 0) PG8_BAR; }
    PG8_BAR;
    if constexpr (Epi::AFTER_DRAIN) { E.fused(acc, cur, wr, wc, fr, fq, lds, wid, lane); S.done(cur); }
#undef PG8_SA
#undef PG8_SB
#undef PG8_STAGE
#undef PG8_LDA
#undef PG8_LDB
#undef PG8_MMA
#undef PG8_WAIT_V
#undef PG8_WAIT_L
#undef PG8_BAR
#undef PG8_SCHED
}
}
#define LAS __attribute__((address_space(3)))
typedef unsigned short bf16_t;
typedef short bf16x8 __attribute__((ext_vector_type(8)));
typedef float f32x4 __attribute__((ext_vector_type(4)));
typedef float f32x16 __attribute__((ext_vector_type(16)));
typedef unsigned u32x4 __attribute__((ext_vector_type(4)));
typedef unsigned u32x2 __attribute__((ext_vector_type(2)));
typedef float f2_t __attribute__((ext_vector_type(2)));
using pg8::pkbf; using pg8::bflo; using pg8::bfhi;

constexpr int NP = 65536, NS = 256, M = NP + NS;
constexpr int MKV = 65536 + 8 * 4128, MKVM = MKV - 256;
constexpr int DM = 1024, NZ = 2816, NZV = 2592, DFF = 2816, NPOS = 4128;
constexpr float EPS = 1e-6f;
constexpr float QSCALE = 0.10206207261596577f * 1.4426950408889634f;
constexpr size_t O_YP = 0, O_YS = 67108864, O_LATP = 67371008, O_KRP = 100925440, O_CVP = 105119744, O_LATS = 105185280, O_KRS = 105316352, O_CVS = 105332736, O_END = 105349120;
constexpr size_t MiB = 1u << 20;
constexpr size_t WS_TAB = 1 * MiB, WS_SSQ = 1 * MiB + 576 * 1024, WS_SSA = 2 * MiB, WS_SSB = 2 * MiB + 512 * 1024, WS_W = 3 * MiB;
constexpr size_t W_IN = 0, W_UQ = W_IN + (size_t)NZ * 1024 * 2, W_KV = W_UQ + (size_t)768 * 768 * 2, W_O = W_KV + (size_t)1024 * 256 * 2, W_GU = W_O + (size_t)1024 * 1024 * 2,
                 W_D = W_GU + (size_t)5632 * 1024 * 2, W_PP = W_D + (size_t)1024 * 2816 * 2, W_PG = W_PP + (size_t)1024 * 256 * 2, W_LAYER = W_PG + (size_t)1024 * 1024 * 2;
constexpr size_t ACT = (size_t)M * 1024 * 2;
constexpr size_t WS_XB0 = WS_W + 2 * W_LAYER, WS_A3 = WS_XB0 + ACT, WS_R1 = WS_A3 + ACT, R1_BYTES = (size_t)M * NZ * 2, WS_R2 = WS_R1 + R1_BYTES, R2_BYTES = 2 * ACT,
                 WS_AKV = WS_R2 + R2_BYTES, WS_KRB = WS_AKV + (size_t)MKV * 256 * 2, WS_PB = WS_KRB + (size_t)MKV * 32 * 2, WS_END = WS_PB + (size_t)M * 256 * 2;
static_assert(WS_END <= (size_t)1 << 30, "workspace map exceeds 1 GiB");
static_assert(2 * (size_t)MKV * 512 * 2 + ACT <= R1_BYTES, "R1 overlay");
static_assert(WS_XB0 % 256 == 0 && WS_R1 % 256 == 0 && WS_R2 % 256 == 0 && WS_AKV % 256 == 0 && WS_KRB % 256 == 0 && WS_PB % 256 == 0, "alignment");

struct Args { const float* in[25]; float* out; unsigned char* ws; int ph_lo, ph_hi, rep_mask, pad; };
typedef const __attribute__((address_space(4))) Args* ArgP;

__device__ __forceinline__ float wave_sum(float v) {
#pragma unroll
    for (int o = 1; o < 64; o <<= 1) v += __shfl_xor(v, o);
    return v;
}
__device__ __forceinline__ void unpack8(const u32x4 w, float (&f)[8]) { f[0] = bflo(w.x); f[1] = bfhi(w.x); f[2] = bflo(w.y); f[3] = bfhi(w.y); f[4] = bflo(w.z); f[5] = bfhi(w.z); f[6] = bflo(w.w); f[7] = bfhi(w.w); }
__device__ __forceinline__ u32x4 pack8(const float (&f)[8]) { u32x4 w; w.x = pkbf(f[0], f[1]); w.y = pkbf(f[2], f[3]); w.z = pkbf(f[4], f[5]); w.w = pkbf(f[6], f[7]); return w; }
__device__ __forceinline__ int row_pos(int r) { return r < NP ? (r & 2047) : 4096 + ((r - NP) & 31); }

__device__ __forceinline__ void tr_item(const float* W, int ldw, int srccol0, const float* g0, const float* g1, int gsplit, bf16_t* WT, int K, int k0, int dstrow0, LAS float* scr, int lane) {
    if (srccol0 >= 0) {
#pragma unroll 16
        for (int i = 0; i < 32; ++i) { const int kk = 2 * i + (lane >> 5), k = k0 + kk; float gv = 1.f; if (g0) gv = (k < gsplit) ? g0[k] : g1[k - gsplit];
            scr[kk * 33 + (lane & 31)] = W[(size_t)k * ldw + srccol0 + (lane & 31)] * gv; }
    } else {
#pragma unroll 8
        for (int i = 0; i < 32; ++i) { const int kk = 2 * i + (lane >> 5); scr[kk * 33 + (lane & 31)] = 0.f; }
    }
    asm volatile("s_waitcnt lgkmcnt(0)" ::: "memory");
    const int c = lane & 7;
#pragma unroll
    for (int j = 0; j < 4; ++j) { const int n = (lane >> 3) + 8 * j; const LAS float* s = scr + (8 * c) * 33 + n;
        u32x4 o; o.x = pkbf(s[0 * 33], s[1 * 33]); o.y = pkbf(s[2 * 33], s[3 * 33]); o.z = pkbf(s[4 * 33], s[5 * 33]); o.w = pkbf(s[6 * 33], s[7 * 33]);
        *(u32x4*)(WT + (size_t)(dstrow0 + n) * K + k0 + 8 * c) = o; }
    asm volatile("s_waitcnt lgkmcnt(0)" ::: "memory");
}

__device__ __forceinline__ void prologue(ArgP ap, LAS unsigned char* lds, int gw, int NGW, int wave, int lane) {
    LAS float* scr = (LAS float*)(lds + wave * 16384);
    unsigned char* ws = ap->ws;
    int off = 0;
    for (int mi = 0; mi < 16; ++mi) {
        const int l = mi >> 3, t = mi & 7;
        const float* W = nullptr; const float* W2 = nullptr; const float* g0 = nullptr; const float* g1 = nullptr; int K = 0, ldw = 0, Nd = 0, mode = 0, gsplit = 0; size_t wo = 0;
        switch (t) {
            case 0: W = ap->in[8] + (size_t)l * 1024 * NZV; K = 1024; ldw = NZV; Nd = NZ; mode = 3; g0 = ap->in[7] + l * 1024; g1 = g0; gsplit = 1024; wo = W_IN; break;
            case 1: W = ap->in[11] + (size_t)l * 768 * 768; K = 768; ldw = 768; Nd = 768; mode = 0; g0 = ap->in[10] + l * 768; g1 = g0; gsplit = 768; wo = W_UQ; break;
            case 2: W = ap->in[13] + (size_t)l * 256 * 1024; K = 256; ldw = 1024; Nd = 1024; mode = 1; wo = W_KV; break;
            case 3: W = ap->in[16] + (size_t)l * 1024 * 1024; K = 1024; ldw = 1024; Nd = 1024; mode = 0; g0 = ap->in[14] + l * 512; g1 = ap->in[15] + l * 512; gsplit = 512; wo = W_O; break;
            case 4: W = ap->in[19] + (size_t)l * 1024 * DFF; W2 = ap->in[20] + (size_t)l * 1024 * DFF; K = 1024; ldw = DFF; Nd = 5632; mode = 2; g0 = ap->in[18] + l * 1024; g1 = g0; gsplit = 1024; wo = W_GU; break;
            case 5: W = ap->in[21] + (size_t)l * DFF * 1024; K = DFF; ldw = 1024; Nd = 1024; mode = 0; wo = W_D; break;
            case 6: W = ap->in[23] + (size_t)l * 256 * 1024; K = 256; ldw = 1024; Nd = 1024; mode = 0; wo = W_PP; break;
            default: W = ap->in[24] + (size_t)l * 1024 * 1024; K = 1024; ldw = 1024; Nd = 1024; mode = 0; wo = W_PG; break;
        }
        bf16_t* WT = (bf16_t*)(ws + WS_W + (size_t)l * W_LAYER + wo);
        const int nkb = K / 64, nitems = nkb * (Nd / 32);
        int start = gw - (off % NGW); if (start < 0) start += NGW;
        for (int it = start; it < nitems; it += NGW) {
            const int nb = it / nkb, kb = it % nkb, n0 = nb * 32; const float* Ws = W; int sc = n0;
            if (mode == 0) { if (n0 >= ldw) sc = -1; }
            else if (mode == 1) { const int part = n0 >> 9, hd = n0 & 511; sc = (hd >> 6) * 128 + part * 64 + (hd & 63); }
            else if (mode == 3) { if (n0 < 1024) { const int t = n0 >> 8, j = n0 & 255; sc = (j < 128) ? 512 + 128 * t + j : 1024 + 128 * t + (j - 128); } else if (n0 < 1536) sc = n0 - 1024; else if (n0 >= ldw) sc = -1; }
            else { const int pn = n0 >> 8, j = n0 & 255; if (j >= 128) Ws = W2; sc = pn * 128 + (j & 127); }
            tr_item(Ws, ldw, sc, g0, g1, gsplit, WT, K, kb * 64, n0, scr, lane);
        }
        off += nitems;
    }
    if (gw == 0 && lane < 16) ((unsigned*)ws)[lane * 64] = 0u;
    f2_t* tab = (f2_t*)(ws + WS_TAB);
    for (int e = gw * 64 + lane; e < NPOS * 16; e += NGW * 64) { const int pos = e >> 4, i = e & 15; const float inv = powf(10000.0f, -(float)i * 0.0625f); const float ang = (float)pos * inv; float s, c; sincosf(ang, &s, &c); tab[e] = (f2_t){c, s}; }
    bf16_t* xb0 = (bf16_t*)(ws + WS_XB0); float* ssA = (float*)(ws + WS_SSA);
    for (int r0 = gw; r0 < M; r0 += 2 * NGW) {
        const bool has2 = r0 + NGW < M; const int r1 = has2 ? r0 + NGW : r0;
        f32x4 v[2][2][2];
#pragma unroll
        for (int i = 0; i < 2; ++i) { const int r = i ? r1 : r0; const float* xr = r < NP ? ap->in[0] + (size_t)r * 1024 : ap->in[1] + (size_t)(r - NP) * 1024;
#pragma unroll
            for (int q = 0; q < 2; ++q) { const int c8 = 8 * (lane + 64 * q); v[i][q][0] = *(const f32x4*)(xr + c8); v[i][q][1] = *(const f32x4*)(xr + c8 + 4); } }
#pragma unroll
        for (int i = 0; i < 2; ++i) { const int r = i ? r1 : r0; float ss = 0.f;
#pragma unroll
            for (int q = 0; q < 2; ++q) { const int c8 = 8 * (lane + 64 * q); const f32x4 v0 = v[i][q][0], v1 = v[i][q][1];
                ss += (v0[0] * v0[0] + v0[1] * v0[1]) + (v0[2] * v0[2] + v0[3] * v0[3]) + (v1[0] * v1[0] + v1[1] * v1[1]) + (v1[2] * v1[2] + v1[3] * v1[3]);
                u32x4 w; w.x = pkbf(v0[0], v0[1]); w.y = pkbf(v0[2], v0[3]); w.z = pkbf(v1[0], v1[1]); w.w = pkbf(v1[2], v1[3]); if (i == 0 || has2) *(u32x4*)(xb0 + (size_t)r * 1024 + c8) = w; }
            ss = wave_sum(ss); if (lane == 0 && (i == 0 || has2)) { ssA[r] = ss; ((float*)(ws + WS_SSQ))[r] = 0.f; } }
    }
}

__device__ __forceinline__ void e1_pass(ArgP ap, int l, int gw, int NGW, int lane) {
    unsigned char* ws = ap->ws;
    const bf16_t* ub = (const bf16_t*)(ws + WS_R1); const bf16_t* gbb = ub + (size_t)M * 512; const bf16_t* zs = ub + (size_t)M * 1024; bf16_t* A3 = (bf16_t*)(ws + WS_A3);
    bf16_t* Akv = (bf16_t*)(ws + WS_AKV); bf16_t* krb = (bf16_t*)(ws + WS_KRB); bf16_t* pb = (bf16_t*)(ws + WS_PB);
    const f2_t* tab = (const f2_t*)(ws + WS_TAB);
    const float* wconv = ap->in[9] + (size_t)l * 3 * 512; const float* gkv = ap->in[12] + l * 256; float* out = ap->out;
    const int c8 = 8 * lane;
#define E1_LOAD(P, rr) do { int r_ = (rr); if (r_ >= M) r_ = gw; const bool isp_ = r_ < NP; const int t_ = isp_ ? (r_ & 2047) : ((r_ - NP) & 31); const int pos_ = isp_ ? t_ : 4096 + t_; \
        const bf16_t* zr_ = zs + (size_t)r_ * 320; const bf16_t* ur_ = ub + (size_t)r_ * 512; \
        P##gb = *(const u32x4*)(gbb + (size_t)r_ * 512 + c8); P##u2 = *(const u32x4*)(ur_ + c8); P##u1 = *(const u32x4*)(ur_ - (t_ >= 1 ? 512 : 0) + c8); P##u0 = *(const u32x4*)(ur_ - (t_ >= 2 ? 1024 : 0) + c8); \
        P##kv = *(const u32x2*)(zr_ + 4 * lane); const float* pr_ = isp_ ? ap->in[5] + ((size_t)l * NP + r_) * 256 : ap->in[6] + ((size_t)l * NS + (r_ - NP)) * 256; P##p = *(const f32x4*)(pr_ + 4 * lane); \
        P##k1 = zr_[256 + (lane & 15)]; P##k2 = zr_[272 + (lane & 15)]; P##cs = tab[pos_ * 16 + (lane & 15)]; } while (0)
    u32x4 w_gb, w_u2, w_u1, w_u0, n_gb, n_u2, n_u1, n_u0; u32x2 w_kv, n_kv; f32x4 w_p, n_p; bf16_t w_k1, w_k2, n_k1, n_k2; f2_t w_cs, n_cs;
    E1_LOAD(w_, gw);
    for (int r = gw; r < M; r += NGW) {
        E1_LOAD(n_, r + NGW);
        const bool isp = r < NP; const int b = isp ? (r >> 11) : ((r - NP) >> 5), t = isp ? (r & 2047) : ((r - NP) & 31), L = isp ? 2048 : 32;
        const int kvrow = isp ? r : NP + b * 4128 + 4096 + t;
        float gb[8], u0[8], u1[8], u2[8];
        unpack8(w_gb, gb); unpack8(w_u2, u2); unpack8(w_u1, u1); unpack8(w_u0, u0);
        if (t < 2) {
            if (isp) {
#pragma unroll
                for (int j = 0; j < 8; ++j) { u0[j] = 0.f; if (t < 1) u1[j] = 0.f; } }
            else { const float* st0 = ap->in[4] + ((size_t)(l * 8 + b) * 2 + t) * 512 + c8; const float* st1 = ap->in[4] + ((size_t)(l * 8 + b) * 2 + 1) * 512 + c8;
#pragma unroll
                for (int j = 0; j < 8; ++j) { u0[j] = st0[j]; if (t < 1) u1[j] = st1[j]; } } }
        float co[8]; float ss = 0.f;
#pragma unroll
        for (int j = 0; j < 8; ++j) { const float cv = u0[j] * wconv[c8 + j] + u1[j] * wconv[512 + c8 + j] + u2[j] * wconv[1024 + c8 + j]; co[j] = gb[j] * cv; ss += co[j] * co[j]; }
        ss = wave_sum(ss); { const float rs = rsqrtf(ss * (1.0f / 512.0f) + EPS);
#pragma unroll
            for (int j = 0; j < 8; ++j) co[j] *= rs; }
        *(u32x4*)(A3 + (size_t)r * 1024 + c8) = pack8(co);
        if (t >= L - 2) { float* d = out + (isp ? O_CVP + ((size_t)(l * 32 + b) * 2 + (t - (L - 2))) * 512 : O_CVS + ((size_t)(l * 8 + b) * 2 + (t - (L - 2))) * 512) + c8;
            *(f32x4*)d = (f32x4){u2[0], u2[1], u2[2], u2[3]}; *(f32x4*)(d + 4) = (f32x4){u2[4], u2[5], u2[6], u2[7]}; }
        { const u32x2 w = w_kv; float v[4] = {bflo(w.x), bfhi(w.x), bflo(w.y), bfhi(w.y)};
            float s2 = (v[0] * v[0] + v[1] * v[1]) + (v[2] * v[2] + v[3] * v[3]); s2 = wave_sum(s2); const float rs = rsqrtf(s2 * (1.0f / 256.0f) + EPS);
            const f32x4 g = *(const f32x4*)(gkv + 4 * lane); f32x4 c = {v[0] * rs * g[0], v[1] * rs * g[1], v[2] * rs * g[2], v[3] * rs * g[3]};
            float* d = out + (isp ? O_LATP + ((size_t)(l * 32 + b) * 2048 + t) * 256 : O_LATS + ((size_t)(l * 8 + b) * 32 + t) * 256) + 4 * lane; *(f32x4*)d = c;
            u32x2 o; o.x = pkbf(c[0], c[1]); o.y = pkbf(c[2], c[3]); *(u32x2*)(Akv + (size_t)kvrow * 256 + 4 * lane) = o; }
        if (lane < 16) { const float x1 = bflo((unsigned)w_k1), x2 = bflo((unsigned)w_k2); const f2_t cs = w_cs;
            const float o1 = x1 * cs.x - x2 * cs.y, o2 = x1 * cs.y + x2 * cs.x;
            float* d = out + (isp ? O_KRP + ((size_t)(l * 32 + b) * 2048 + t) * 32 : O_KRS + ((size_t)(l * 8 + b) * 32 + t) * 32); d[lane] = o1; d[lane + 16] = o2;
            krb[pg8::krf_off(kvrow, lane)] = (bf16_t)(pkbf(o1, 0.f) & 0xffffu); krb[pg8::krf_off(kvrow, 16 + lane)] = (bf16_t)(pkbf(o2, 0.f) & 0xffffu); }
        { const f32x4 v = w_p;
            u32x2 o; o.x = pkbf(v[0], v[1]); o.y = pkbf(v[2], v[3]); *(u32x2*)(pb + (size_t)r * 256 + 4 * lane) = o; }
        w_gb = n_gb; w_u2 = n_u2; w_u1 = n_u1; w_u0 = n_u0; w_kv = n_kv; w_p = n_p; w_k1 = n_k1; w_k2 = n_k2; w_cs = n_cs;
    }
#undef E1_LOAD
    for (int j0 = gw; j0 < 8 * 4096; j0 += 4 * NGW) {
        f32x4 v[4]; float kr[4];
#pragma unroll
        for (int i = 0; i < 4; ++i) { const int j = j0 + i * NGW, jc = j < 8 * 4096 ? j : j0; const int b = jc >> 12, jj = jc & 4095;
            v[i] = *(const f32x4*)(ap->in[2] + ((size_t)(l * 8 + b) * 4096 + jj) * 256 + 4 * lane); kr[i] = ap->in[3][((size_t)(l * 8 + b) * 4096 + jj) * 32 + (lane & 31)]; }
#pragma unroll
        for (int i = 0; i < 4; ++i) { const int j = j0 + i * NGW; if (j < 8 * 4096) { const int b = j >> 12, jj = j & 4095; const size_t kvrow = (size_t)NP + b * 4128 + jj;
            u32x2 o; o.x = pkbf(v[i][0], v[i][1]); o.y = pkbf(v[i][2], v[i][3]); *(u32x2*)(Akv + kvrow * 256 + 4 * lane) = o;
            if (lane < 32) krb[pg8::krf_off((int)kvrow, lane)] = (bf16_t)(pkbf(kr[i], 0.f) & 0xffffu); } }
    }
}

__device__ __forceinline__ void resnorm_pass(const float* xa, const float* xs, const bf16_t* xbin, const bf16_t* yb, const float* g, bf16_t* xb, float* ss_out, float* ss_zero, int gw, int NGW, int lane) {
    (void)xa; (void)xs;
    f32x4 gv[2][2];
#pragma unroll
    for (int q = 0; q < 2; ++q) { gv[q][0] = *(const f32x4*)(g + 8 * (lane + 64 * q)); gv[q][1] = *(const f32x4*)(g + 8 * (lane + 64 * q) + 4); }
    u32x4 yw[2][2], xw[2][2], yn[2][2], xn[2][2];
#define RN_LOAD(dy, dx, rbase) do { _Pragma("unroll") for (int i = 0; i < 2; ++i) { int r_ = (rbase) + i * NGW; if (r_ >= M) r_ = (rbase) < M ? (rbase) : gw; \
        _Pragma("unroll") for (int q = 0; q < 2; ++q) { const int c8 = 8 * (lane + 64 * q); dy[i][q] = *(const u32x4*)(yb + (size_t)r_ * 1024 + c8); dx[i][q] = *(const u32x4*)(xbin + (size_t)r_ * 1024 + c8); } } } while (0)
    RN_LOAD(yw, xw, gw);
    for (int r0 = gw; r0 < M; r0 += 2 * NGW) {
        RN_LOAD(yn, xn, r0 + 2 * NGW);
#pragma unroll
        for (int i = 0; i < 2; ++i) { const int r = r0 + i * NGW; const bool ok = r < M; float y[2][8], x[2][8]; float s2 = 0.f;
#pragma unroll
            for (int q = 0; q < 2; ++q) { unpack8(yw[i][q], y[q]); unpack8(xw[i][q], x[q]);
#pragma unroll
                for (int j = 0; j < 8; ++j) s2 += y[q][j] * y[q][j]; }
            s2 = wave_sum(s2); const float rs = rsqrtf(s2 * (1.0f / 1024.0f) + EPS); float s3 = 0.f;
#pragma unroll
            for (int q = 0; q < 2; ++q) { float o[8];
#pragma unroll
                for (int j = 0; j < 4; ++j) { o[j] = x[q][j] + y[q][j] * rs * gv[q][0][j]; o[4 + j] = x[q][4 + j] + y[q][4 + j] * rs * gv[q][1][j]; }
                const u32x4 w = pack8(o);
                if (ss_out) { float ob[8]; unpack8(w, ob);
#pragma unroll
                    for (int j = 0; j < 8; ++j) s3 += ob[j] * ob[j]; }
                if (ok) *(u32x4*)(xb + (size_t)r * 1024 + 8 * (lane + 64 * q)) = w; }
            if (ss_out) s3 = wave_sum(s3);
            if (lane == 0 && ok) { if (ss_out) ss_out[r] = s3; if (ss_zero) ss_zero[r] = 0.f; } }
#pragma unroll
        for (int i = 0; i < 2; ++i)
#pragma unroll
            for (int q = 0; q < 2; ++q) { yw[i][q] = yn[i][q]; xw[i][q] = xn[i][q]; }
    }
#undef RN_LOAD
}

#define MFMA32(a, b, c) __builtin_amdgcn_mfma_f32_32x32x16_bf16((a), (b), (c), 0, 0, 0)
__device__ __forceinline__ void swap32(float x, float& a, float& b) { auto r = __builtin_amdgcn_permlane32_swap(__float_as_uint(x), __float_as_uint(x), false, false); a = __uint_as_float(r[0]); b = __uint_as_float(r[1]); }
__device__ __forceinline__ float max_x32(float x) { float a, b; swap32(x, a, b); return fmaxf(a, b); }
__device__ __forceinline__ float sum_x32(float x) { float a, b; swap32(x, a, b); return a + b; }
template <int NQB>
__device__ __forceinline__ void attn_unit(const bf16_t* __restrict__ Q, const bf16_t* __restrict__ Kn, const bf16_t* __restrict__ Kr, const bf16_t* __restrict__ VT, bf16_t* A3,
                                          int qrow0, int kvrow0, int nkb, int h, int lane, LAS float* red) {
    const int r = lane & 31, hh = lane >> 5;
    LAS bf16x8* qlds = (LAS bf16x8*)((LAS unsigned char*)red + 4096 + h * 12288) + lane;
#pragma unroll
    for (int qb = 0; qb < NQB; ++qb)
#pragma unroll
        for (int s = 0; s < 6; ++s) qlds[(qb * 6 + s) * 64] = *(const bf16x8*)(Q + (size_t)(qrow0 + 32 * qb + r) * 768 + h * 96 + 16 * s + 8 * hh);
    f32x16 O[NQB][2]; float mrun[NQB], lrun[NQB];
#pragma unroll
    for (int qb = 0; qb < NQB; ++qb) { mrun[qb] = -1e30f; lrun[qb] = 0.f;
#pragma unroll
        for (int db = 0; db < 2; ++db)
#pragma unroll
            for (int i = 0; i < 16; ++i) O[qb][db][i] = 0.f; }
    const int pr = (r & 0x13) | ((r & 4) << 1) | ((r & 8) >> 1);
    const int blk0 = kvrow0 >> 5; (void)pr;
    const bf16_t* kp = Kn + ((size_t)(blk0 * 8 + h) * 256 + lane) * 8;
    const bf16_t* krp = Kr + ((size_t)blk0 * 128 + lane) * 8;
    const bf16_t* vp = VT + ((size_t)(blk0 * 8 + h) * 256 + lane) * 8;
    bf16x8 Kf[6];
#pragma unroll
    for (int s = 0; s < 4; ++s) Kf[s] = *(const bf16x8*)(kp + 512 * s);
    Kf[4] = *(const bf16x8*)(krp); Kf[5] = *(const bf16x8*)(krp + 512);
    for (int kb = 0; kb < nkb; ++kb) {
        asm volatile("" ::: "memory");
        bf16x8 Vf[2][2];
#pragma unroll
        for (int db = 0; db < 2; ++db)
#pragma unroll
            for (int s2 = 0; s2 < 2; ++s2) Vf[db][s2] = *(const bf16x8*)(vp + (size_t)kb * 16384 + (db * 2 + s2) * 512);
        bf16x8 Kx[6];
        { const int kn = (kb + 1 < nkb) ? kb + 1 : kb;
#pragma unroll
            for (int s = 0; s < 4; ++s) Kx[s] = *(const bf16x8*)(kp + (size_t)kn * 16384 + 512 * s);
            Kx[4] = *(const bf16x8*)(krp + (size_t)kn * 1024); Kx[5] = *(const bf16x8*)(krp + (size_t)kn * 1024 + 512); }
#pragma unroll
        for (int qb = 0; qb < NQB; ++qb) {
            f32x16 X;
#pragma unroll
            for (int i = 0; i < 16; ++i) X[i] = 0.f;
#pragma unroll
            for (int s = 0; s < 6; ++s) X = MFMA32(Kf[s], qlds[(qb * 6 + s) * 64], X);
            float mx = X[0];
#pragma unroll
            for (int i = 1; i < 16; ++i) mx = fmaxf(mx, X[i]);
            mx = max_x32(mx);
            const float mnew = fmaxf(mrun[qb], mx), alpha = __builtin_amdgcn_exp2f(mrun[qb] - mnew); mrun[qb] = mnew;
            float ps = 0.f;
#pragma unroll
            for (int i = 0; i < 16; ++i) { X[i] = __builtin_amdgcn_exp2f(X[i] - mnew); ps += X[i]; }
            lrun[qb] = lrun[qb] * alpha + ps;
#pragma unroll
            for (int db = 0; db < 2; ++db)
#pragma unroll
                for (int i = 0; i < 16; ++i) O[qb][db][i] *= alpha;
#pragma unroll
            for (int s2 = 0; s2 < 2; ++s2) { u32x4 pw; pw.x = pkbf(X[8 * s2], X[8 * s2 + 1]); pw.y = pkbf(X[8 * s2 + 2], X[8 * s2 + 3]); pw.z = pkbf(X[8 * s2 + 4], X[8 * s2 + 5]); pw.w = pkbf(X[8 * s2 + 6], X[8 * s2 + 7]);
                const bf16x8 xs = __builtin_bit_cast(bf16x8, pw);
#pragma unroll
                for (int db = 0; db < 2; ++db) O[qb][db] = MFMA32(Vf[db][s2], xs, O[qb][db]); }
        }
#pragma unroll
        for (int s = 0; s < 6; ++s) Kf[s] = Kx[s];
    }
#pragma unroll
    for (int qb = 0; qb < NQB; ++qb) { const float lt = sum_x32(lrun[qb]); const float inv = 1.0f / lt; float ss = 0.f;
#pragma unroll
        for (int db = 0; db < 2; ++db)
#pragma unroll
            for (int i = 0; i < 16; ++i) { O[qb][db][i] *= inv; ss += O[qb][db][i] * O[qb][db][i]; }
        ss = sum_x32(ss);
        if (hh == 0) red[h * 64 + qb * 32 + r] = ss; }
    __syncthreads();
#pragma unroll
    for (int qb = 0; qb < NQB; ++qb) { float tot = 0.f;
#pragma unroll
        for (int w = 0; w < 8; ++w) tot += red[w * 64 + qb * 32 + r];
        const float rs = rsqrtf(tot * (1.0f / 512.0f) + EPS);
        bf16_t* op = A3 + (size_t)(qrow0 + 32 * qb + r) * 1024 + 512 + h * 64 + 4 * hh;
#pragma unroll
        for (int db = 0; db < 2; ++db)
#pragma unroll
            for (int g = 0; g < 4; ++g) { u32x2 w; w.x = pkbf(O[qb][db][4 * g] * rs, O[qb][db][4 * g + 1] * rs); w.y = pkbf(O[qb][db][4 * g + 2] * rs, O[qb][db][4 * g + 3] * rs);
                *(u32x2*)(op + 32 * db + 8 * g) = w; } }
    __syncthreads();
}


#define MFMA32T(a, b, c) __builtin_amdgcn_mfma_f32_32x32x16_bf16((a), (b), (c), 0, 0, 0)
__device__ __forceinline__ int crow32(int i, int hh) { return (i & 3) + 8 * (i >> 2) + 4 * hh; }
template <bool DUAL, class F>
__device__ __forceinline__ void tail_tiles(const bf16_t* A, int lda, const bf16_t* Bt, const bf16_t* Bt2, int ldb, int K, int mt, int nt, int bid, int G, int wave, int lane, LAS float* red, const F& f, int boff = 0) {
    const int r = lane & 31, hh = lane >> 5; int b0 = bid - boff; if (b0 < 0) b0 += G;
    for (int t = b0; t < mt * nt; t += G) { const int mb = t / nt, nb = t % nt;
        const bf16_t* ap = A + (size_t)(mb * 32 + r) * lda + wave * 16 + 8 * hh; const int brow = f.brow(nb);
        const bf16_t* bp = Bt + (size_t)(brow + r) * ldb + wave * 16 + 8 * hh; const bf16_t* bp2 = DUAL ? Bt2 + (size_t)(brow + r) * ldb + wave * 16 + 8 * hh : bp;
        f32x16 acc, acc2;
#pragma unroll
        for (int i = 0; i < 16; ++i) { acc[i] = 0.f; acc2[i] = 0.f; }
#pragma unroll 8
        for (int k = 0; k < K; k += 128) { const bf16x8 av = *(const bf16x8*)(ap + k); acc = MFMA32T(av, *(const bf16x8*)(bp + k), acc); if (DUAL) acc2 = MFMA32T(av, *(const bf16x8*)(bp2 + k), acc2); }
#pragma unroll
        for (int i = 0; i < 16; ++i) { red[(wave * 16 + i) * 64 + lane] = acc[i]; if (DUAL) red[8192 + (wave * 16 + i) * 64 + lane] = acc2[i]; }
        __syncthreads();
#pragma unroll
        for (int ii = 0; ii < 2; ++ii) { const int i = 2 * wave + ii; float v = 0.f, v2 = 0.f;
#pragma unroll
            for (int w = 0; w < 8; ++w) { v += red[(w * 16 + i) * 64 + lane]; if (DUAL) v2 += red[8192 + (w * 16 + i) * 64 + lane]; }
            f(v, v2, mb * 32 + crow32(i, hh), nb * 32, r); }
        __syncthreads();
    }
}
__device__ __forceinline__ bf16_t f2bf1(float v) { return (bf16_t)(pkbf(v, 0.f) & 0xffffu); }
struct TPlain { bf16_t* O; size_t ldo; __device__ __forceinline__ int brow(int nb) const { return nb * 32; }
    __device__ __forceinline__ void operator()(float v, float, int row, int c0, int r) const { O[(size_t)row * ldo + c0 + r] = f2bf1(v); } };
struct TKF { bf16_t* O; __device__ __forceinline__ int brow(int nb) const { return nb * 32; }
    __device__ __forceinline__ void operator()(float v, float, int row, int c0, int r) const { const int col = c0 + r; O[pg8::kf_off(MKVM + row, col >> 6, col & 56) + (col & 7)] = f2bf1(v); } };
struct TVF { bf16_t* O; __device__ __forceinline__ int brow(int nb) const { return nb * 32; }
    __device__ __forceinline__ void operator()(float v, float, int row, int c0, int r) const { const int kv = MKVM + c0 + r; O[pg8::vf_off(row >> 6, row & 63, kv & ~7) + (kv & 7)] = f2bf1(v); } };
struct TU { bf16_t* ub; const float* ss; int row_base; __device__ __forceinline__ int brow(int nb) const { return (nb >> 2) * 256 + (nb & 3) * 32; }
    __device__ __forceinline__ void operator()(float v, float v2, int row, int c0, int r) const { row += row_base; const float sc = rsqrtf(ss[row] * (1.0f / 1024.0f) + EPS); ub[(size_t)row * 512 + c0 + r] = f2bf1((v * sc) * (v2 * sc)); } };
struct TG1b { bf16_t* gbb; bf16_t* Aq; bf16_t* zs; float* ssq; const float* ss; int row_base; __device__ __forceinline__ int brow(int nb) const { return 1024 + nb * 32; }
    __device__ __forceinline__ void operator()(float v, float, int row, int c0, int r) const { row += row_base; const float sc = rsqrtf(ss[row] * (1.0f / 1024.0f) + EPS); const bf16_t o = f2bf1(v * sc); const int nb = c0 >> 5;
        if (nb < 16) gbb[(size_t)row * 512 + c0 + r] = o;
        else if (nb < 40) { Aq[(size_t)row * 768 + (c0 - 512) + r] = o; const float a = bflo((unsigned)o); float q = a * a; q += __shfl_xor(q, 1); q += __shfl_xor(q, 2); q += __shfl_xor(q, 4); q += __shfl_xor(q, 8); q += __shfl_xor(q, 16); if (r == 0) atomicAdd(ssq + row, q); }
        else zs[(size_t)row * 320 + (c0 - 1280) + r] = o; } };
struct TRowScale { bf16_t* O; int ldo; const float* ss; int row_base; __device__ __forceinline__ int brow(int nb) const { return nb * 32; }
    __device__ __forceinline__ void operator()(float v, float, int row, int c0, int r) const { row += row_base; const float sc = rsqrtf(ss[row] * (1.0f / 1024.0f) + EPS); O[(size_t)row * ldo + c0 + r] = f2bf1(v * sc); } };
struct TQRope { bf16_t* O; const f2_t* tab; int row_base; const float* ssq; __device__ __forceinline__ int brow(int nb) const { return nb * 32; }
    __device__ __forceinline__ void operator()(float v, float, int row, int c0, int r) const { row += row_base;
        if ((c0 % 96) == 64) { const float o = __shfl_xor(v, 16); const f2_t cs = tab[row_pos(row) * 16 + (r & 15)]; v = (r < 16) ? (v * cs.x - o * cs.y) : (o * cs.y + v * cs.x); }
        O[(size_t)row * 768 + c0 + r] = f2bf1(v * QSCALE * rsqrtf(ssq[row] * (1.0f / 768.0f) + EPS)); } };
struct TSwiGLU { bf16_t* O; const float* ss; int row_base; __device__ __forceinline__ int brow(int nb) const { return (nb >> 2) * 256 + (nb & 3) * 32; }
    __device__ __forceinline__ void operator()(float v, float v2, int row, int c0, int r) const { row += row_base; const float sc = rsqrtf(ss[row] * (1.0f / 1024.0f) + EPS); const float g = v * sc, up = v2 * sc;
        O[(size_t)row * DFF + c0 + r] = f2bf1(g * pg8::fsigmoid(g) * up); } };
struct TPle { const bf16_t* xin; const bf16_t* pp; bf16_t* xbn; float* Y; float* ssn; int last; int row_base; __device__ __forceinline__ int brow(int nb) const { return nb * 32; }
    __device__ __forceinline__ void operator()(float v, float, int row, int c0, int r) const { row += row_base; const size_t off = (size_t)row * 1024 + c0 + r;
        const float x3 = bflo((unsigned)xin[off]) + pg8::fsigmoid(v) * bflo((unsigned)pp[off]);
        if (last) Y[off] = x3;
        else { xbn[off] = f2bf1(x3); float s = x3 * x3; s += __shfl_xor(s, 1); s += __shfl_xor(s, 2); s += __shfl_xor(s, 4); s += __shfl_xor(s, 8); s += __shfl_xor(s, 16); if (r == 0) atomicAdd(ssn + row, s); } } };

#define XB_TMO      128
#define XB_XCNT(j)  (256  + 64 * (j))
#define XB_XSUB(j)  (1280 + 64 * (j))
#define XB_XGEN(j)  (2304 + 64 * (j))
#define XB_TOP      3328
#define XB_TOPGEN   3392
#define XCD_BAR_WORDS 3456
#define XB_SPIN_CAP (1u << 18)

__device__ __forceinline__ unsigned xb_ld(unsigned* p)              { return __hip_atomic_load(p, __ATOMIC_RELAXED, __HIP_MEMORY_SCOPE_AGENT); }
__device__ __forceinline__ unsigned xb_add(unsigned* p, unsigned v) { return __hip_atomic_fetch_add(p, v, __ATOMIC_RELAXED, __HIP_MEMORY_SCOPE_AGENT); }
__device__ __forceinline__ unsigned xb_xcc_id() { return (unsigned)__builtin_amdgcn_s_getreg((3 << 11) | 20) & 0xFu; }
#define XB_SPIN(cond, bar) do { unsigned _sp = 0; while (cond) { __builtin_amdgcn_s_sleep(1); \
    if ((++_sp & 255u) == 0u) { if (xb_ld(&(bar)[XB_TMO])) break; if (_sp > XB_SPIN_CAP) { atomicAdd(&(bar)[XB_TMO], 1u); break; } } } } while (0)

struct XcdBarrier {
    unsigned* bar; unsigned x;
    volatile LAS unsigned* st;
};

__device__ __forceinline__ XcdBarrier xcd_barrier_post(unsigned* bar, volatile LAS unsigned* st) {
    XcdBarrier b; b.bar = bar; b.x = xb_xcc_id(); b.st = st;
    if (threadIdx.x == 0) (void)xb_add(&bar[XB_XCNT(b.x)], 1u);
    return b;
}
__device__ __forceinline__ void xcd_barrier_complete(unsigned* bar, unsigned x, unsigned& nloc, unsigned& nx) {
    const unsigned G = gridDim.x * gridDim.y * gridDim.z;
    unsigned sum, cnt, mine, sp = 0u;
    for (;;) {
        sum = 0u; cnt = 0u; mine = 0u;
#pragma unroll
        for (unsigned j = 0; j < 16; ++j) { const unsigned c = xb_ld(&bar[XB_XCNT(j)]); sum += c; cnt += (c > 0u) ? 1u : 0u; mine = (j == x) ? c : mine; }
        if (sum == G) break;
        __builtin_amdgcn_s_sleep(1);
        if ((++sp & 255u) == 0u) { if (xb_ld(&bar[XB_TMO])) break; if (sp > XB_SPIN_CAP) { atomicAdd(&bar[XB_TMO], 1u); break; } }
    }
    nloc = mine > 0u ? mine : 1u; nx = cnt > 0u ? cnt : 1u;
}

__device__ __forceinline__ void xcd_barrier(const XcdBarrier& b) {
    asm volatile("s_waitcnt vmcnt(0)" ::: "memory");
    __syncthreads();
    if (threadIdx.x == 0) {
        unsigned* bar = b.bar;
        __builtin_amdgcn_s_waitcnt(0);
        unsigned nloc = b.st[0], nx = b.st[1];
        if (nloc == 0u) { xcd_barrier_complete(bar, b.x, nloc, nx); b.st[0] = nloc; b.st[1] = nx; }
        const unsigned old = xb_add(&bar[XB_XSUB(b.x)], 1u);
        const unsigned gen = old / nloc;
        if (old + 1u == (gen + 1u) * nloc) {
            __builtin_amdgcn_fence(__ATOMIC_RELEASE, "agent");
            asm volatile("s_waitcnt vmcnt(0)" ::: "memory");
            const unsigned og = xb_add(&bar[XB_TOP], 1u);
            const unsigned tg = og / nx;
            if (og + 1u == (tg + 1u) * nx) xb_add(&bar[XB_TOPGEN], 1u);
            else XB_SPIN(xb_ld(&bar[XB_TOPGEN]) == tg, bar);
            __builtin_amdgcn_fence(__ATOMIC_ACQUIRE, "agent");
            xb_add(&bar[XB_XGEN(b.x)], 1u);
            asm volatile("s_waitcnt vmcnt(0)" ::: "memory");
        } else {
            XB_SPIN(xb_ld(&bar[XB_XGEN(b.x)]) == gen, bar);
            __builtin_amdgcn_fence(__ATOMIC_ACQUIRE, "agent");
            asm volatile("s_waitcnt vmcnt(0)" ::: "memory");
        }
    }
    __syncthreads();
}

constexpr int LDS_BYTES = 147456, XB_LDS_OFF = 140032, XB_WS_WORD = 4096, CTL_ZERO_BYTES = 65536;
constexpr int PH_PER_LAYER = 10, N_PHASES = 1 + 2 * PH_PER_LAYER;
__global__ void __launch_bounds__(512, 2) fwd_megakernel(Args a_) {
    extern __shared__ __attribute__((aligned(16))) unsigned char lds_raw[];
    cg::grid_group grid = cg::this_grid();
    LAS unsigned char* lds = (LAS unsigned char*)lds_raw;
    int ph_lo, ph_hi; XcdBarrier xbar;
    { ArgP ap0 = (ArgP)__builtin_amdgcn_kernarg_segment_ptr(); ph_lo = ap0->ph_lo; ph_hi = ap0->ph_hi;
      LAS unsigned* stw = (LAS unsigned*)(lds + XB_LDS_OFF); if (threadIdx.x < 2) stw[threadIdx.x] = 0u; __syncthreads();
      xbar = xcd_barrier_post((unsigned*)ap0->ws + XB_WS_WORD, (volatile LAS unsigned*)stw); }
    int rep_done = 0; (void)rep_done;
    for (int ph = ph_lo; ph < ph_hi; ++ph) {
        ArgP ap = (ArgP)__builtin_amdgcn_kernarg_segment_ptr(); asm volatile("" : "+s"(ap));
        int G = gridDim.x, bid = blockIdx.x; asm volatile("" : "+s"(G), "+s"(bid));
        int tid = threadIdx.x; asm volatile("" : "+v"(tid));
        const int lane = tid & 63, wave = __builtin_amdgcn_readfirstlane(tid >> 6);
        const int gw = bid * 8 + wave, NGW = G * 8;
        unsigned char* ws = ap->ws;
        float* Y = ap->out;
        bf16_t* xb1 = (bf16_t*)ap->out;
        float* ssA = (float*)(ws + WS_SSA); float* ssB = (float*)(ws + WS_SSB);
        bf16_t* xb0 = (bf16_t*)(ws + WS_XB0); bf16_t* A3 = (bf16_t*)(ws + WS_A3);
        bf16_t* R1 = (bf16_t*)(ws + WS_R1); bf16_t* R2 = (bf16_t*)(ws + WS_R2);
        bf16_t* Akv = (bf16_t*)(ws + WS_AKV); bf16_t* krb = (bf16_t*)(ws + WS_KRB); bf16_t* pb = (bf16_t*)(ws + WS_PB);
        bf16_t* Knb = R1; bf16_t* VTb = R1 + (size_t)MKV * 512; bf16_t* mixb = R1 + (size_t)2 * MKV * 512;
        bf16_t* Aq = R2; bf16_t* qbuf = R2 + (size_t)M * 768; bf16_t* fb = R2; bf16_t* ppb = R2 + (size_t)M * 1024;
        if (ph == 0) {
#ifndef OFF_P0
 prologue(ap, lds, gw, NGW, wave, lane);
#endif
 }
        else {
            const int l = (ph - 1) / PH_PER_LAYER, k = (ph - 1) % PH_PER_LAYER;
            const unsigned char* wl = ws + WS_W + (size_t)l * W_LAYER;
            int nplain = 0; pg8::Gemm gA{nullptr, nullptr, 0, 0, 0}, gB{nullptr, nullptr, 0, 0, 0}; bf16_t* oA = nullptr; bf16_t* oB = nullptr; int ldA = 0, ldB = 0, mdA = 0, mdB = 0;
            if (k == 0) {
                const bf16_t* xin_ = l == 0 ? xb0 : xb1; pg8::Gemm g{xin_, (const bf16_t*)(wl + W_IN), NP, NZ, 1024}; pg8::StaticOrder S; S.init(NP, NZ, G, bid);
                float* ssq = (float*)(ws + WS_SSQ); bf16_t* gbb = R1 + (size_t)M * 512; bf16_t* zsb = R1 + (size_t)M * 1024;
                pg8::EpiG1 E{R1, gbb, Aq, zsb, ssq, ssA, 1.0f / 1024.0f, EPS};

#ifndef OFF_G1
                pg8::gemm_phase<pg8::EpiG1, pg8::StaticOrder, true, true>(lds, g, S, E);
#endif
                { const TU T{R1, ssA, NP}; tail_tiles<true>(xin_ + (size_t)NP * 1024, 1024, (const bf16_t*)(wl + W_IN), (const bf16_t*)(wl + W_IN) + (size_t)128 * 1024, 1024, 1024, 8, 16, bid, G, wave, lane, (LAS float*)lds, T, 136 % G); }
                { const TG1b T{gbb, Aq, zsb, ssq, ssA, NP}; tail_tiles<false>(xin_ + (size_t)NP * 1024, 1024, (const bf16_t*)(wl + W_IN), nullptr, 1024, 1024, 8, 49, bid, G, wave, lane, (LAS float*)lds, T); }

            } else if (k == 1) {
#ifndef OFF_E1
 e1_pass(ap, l, gw, NGW, lane);
#endif

            } else if (k == 2) {
                pg8::Gemm g{Aq, (const bf16_t*)(wl + W_UQ), NP, 768, 768}; pg8::StaticOrder S; S.init(NP, 768, G, bid);
                pg8::EpiQRope E{qbuf, (const f2_t*)(ws + WS_TAB), QSCALE, (const float*)(ws + WS_SSQ)};

#ifndef OFF_G2
                pg8::gemm_phase<pg8::EpiQRope, pg8::StaticOrder, true, true>(lds, g, S, E);
#endif
                { const TQRope T{qbuf, (const f2_t*)(ws + WS_TAB), NP, (const float*)(ws + WS_SSQ)}; tail_tiles<false>(Aq + (size_t)NP * 768, 768, (const bf16_t*)(wl + W_UQ), nullptr, 768, 768, 8, 24, bid, G, wave, lane, (LAS float*)lds, T); }
                { const TKF T{Knb}; tail_tiles<false>(Akv + (size_t)MKVM * 256, 256, (const bf16_t*)(wl + W_KV), nullptr, 256, 256, 8, 16, bid, G, wave, lane, (LAS float*)lds, T, 192 % G); }
                { const TVF T{VTb}; tail_tiles<false>((const bf16_t*)(wl + W_KV) + (size_t)512 * 256, 256, Akv + (size_t)MKVM * 256, nullptr, 256, 256, 16, 8, bid, G, wave, lane, (LAS float*)lds, T, 64 % G); }

                nplain = 2;
                gA = pg8::Gemm{Akv, (const bf16_t*)(wl + W_KV), MKVM, 512, 256}; oA = Knb; ldA = 512; mdA = 1;
                gB = pg8::Gemm{(const bf16_t*)(wl + W_KV) + (size_t)512 * 256, Akv, 512, MKVM, 256}; oB = VTb; ldB = MKV; mdB = 2;
            } else if (k == 3) {
                LAS float* red = (LAS float*)lds;
                LAS int* slot = (LAS int*)(lds + 2048);
                for (int qi = 0; qi < 8; ++qi) { const int x = ((bid & 7) + qi) & 7; unsigned* ctr = (unsigned*)ws + (l * 8 + x) * 64;
                    for (;;) {
                        if (tid == 0) *slot = (int)__hip_atomic_fetch_add(ctr, 1u, __ATOMIC_RELAXED, __HIP_MEMORY_SCOPE_AGENT);
                        __syncthreads();
                        const int u = *slot;
                        __syncthreads();
                        if (u >= 129) break;
#ifndef OFF_ATT
                        if (u == 0) attn_unit<1>(qbuf, Knb, krb, VTb, A3, NP + x * 32, NP + x * 4128, 129, wave, lane, red);
                        else { const int i = u - 1, b = x + 8 * (i >> 5), c = 31 - (i & 31); attn_unit<2>(qbuf, Knb, krb, VTb, A3, b * 2048 + 64 * c, b * 2048, 2 * (c + 1), wave, lane, red); }
#endif
                    } }
            } else if (k == 4) {
                nplain = 2;
                gA = pg8::Gemm{A3, (const bf16_t*)(wl + W_O), NP, 1024, 1024}; oA = mixb; ldA = 1024;
                gB = pg8::Gemm{pb, (const bf16_t*)(wl + W_PP), NP, 1024, 256}; oB = ppb; ldB = 1024;
                { const TPlain T{mixb + (size_t)NP * 1024, 1024}; tail_tiles<false>(A3 + (size_t)NP * 1024, 1024, (const bf16_t*)(wl + W_O), nullptr, 1024, 1024, 8, 32, bid, G, wave, lane, (LAS float*)lds, T); }
                { const TPlain T{ppb + (size_t)NP * 1024, 1024}; tail_tiles<false>(pb + (size_t)NP * 256, 256, (const bf16_t*)(wl + W_PP), nullptr, 256, 256, 8, 32, bid, G, wave, lane, (LAS float*)lds, T); }
            } else if (k == 5) {
                resnorm_pass(nullptr, nullptr, l == 0 ? xb0 : xb1, mixb, ap->in[17] + l * 1024, xb0, ssB, (float*)(ws + WS_SSQ), gw, NGW, lane);
            } else if (k == 6) {
                pg8::Gemm g{xb0, (const bf16_t*)(wl + W_GU), NP, 5632, 1024}; pg8::StaticOrder S; S.init(NP, 5632, G, bid);
                pg8::EpiSwiGLU E{R1, DFF, ssB, 1.0f / 1024.0f, EPS};

#ifndef OFF_G4
                pg8::gemm_phase<pg8::EpiSwiGLU, pg8::StaticOrder, true, true>(lds, g, S, E);
#endif
                { const TSwiGLU T{R1, ssB, NP}; tail_tiles<true>(xb0 + (size_t)NP * 1024, 1024, (const bf16_t*)(wl + W_GU), (const bf16_t*)(wl + W_GU) + (size_t)128 * 1024, 1024, 1024, 8, DFF / 32, bid, G, wave, lane, (LAS float*)lds, T); }

            } else if (k == 7) {
                nplain = 1; gA = pg8::Gemm{R1, (const bf16_t*)(wl + W_D), NP, 1024, DFF}; oA = fb; ldA = 1024;
                { const TPlain T{fb + (size_t)NP * 1024, 1024}; tail_tiles<false>(R1 + (size_t)NP * DFF, DFF, (const bf16_t*)(wl + W_D), nullptr, DFF, DFF, 8, 32, bid, G, wave, lane, (LAS float*)lds, T); }
            } else if (k == 8) {
                resnorm_pass(nullptr, nullptr, xb0, fb, ap->in[22] + l * 1024, xb0, nullptr, ssA, gw, NGW, lane);
            } else {
                pg8::Gemm g{xb0, (const bf16_t*)(wl + W_PG), NP, 1024, 1024}; pg8::StaticOrder S; S.init(NP, 1024, G, bid);
                pg8::EpiPle E{xb0, ppb, xb1, Y, ssA, l == 1 ? 1 : 0};

#ifndef OFF_G6
                pg8::gemm_phase<pg8::EpiPle, pg8::StaticOrder, true, true>(lds, g, S, E);
#endif
                { const TPle T{xb0, ppb, xb1, Y, ssA, l == 1 ? 1 : 0, NP}; tail_tiles<false>(xb0 + (size_t)NP * 1024, 1024, (const bf16_t*)(wl + W_PG), nullptr, 1024, 1024, 8, 32, bid, G, wave, lane, (LAS float*)lds, T); }

            }
            for (int j = 0; j < nplain; ++j) {
                const pg8::Gemm g = j == 0 ? gA : gB; pg8::StaticOrder S; S.init(g.M, g.N, G, bid);
                pg8::EpiBf16M E{j == 0 ? oA : oB, j == 0 ? ldA : ldB, j == 0 ? mdA : mdB};

#ifndef OFF_GP
                pg8::gemm_phase<pg8::EpiBf16M, pg8::StaticOrder, true, true>(lds, g, S, E);
#endif

            }
        }
        if (ph + 1 < ph_hi) { if (ph_lo < 0) grid.sync(); else xcd_barrier(xbar); }
#ifdef REP_MASK
        if (ph >= 1) { const int kq = (ph - 1) % PH_PER_LAYER; if (!rep_done && ((REP_MASK >> kq) & 1)) { rep_done = 1; --ph; } else rep_done = 0; }
#endif
    }
}

extern "C" void kernel_launch(void* const* d_in, const int* in_sizes, int n_in, void* d_out, int out_size, void* d_ws, size_t ws_size, hipStream_t stream) {
    static int grid = 0;
    if (grid == 0) {
        if (n_in != 25 || (size_t)out_size != O_END || ws_size < WS_END) { fprintf(stderr, "kernel_launch: unexpected shapes: n_in %d out %d ws %zu (need %zu)\n", n_in, out_size, ws_size, (size_t)WS_END); grid = -1; return; }
        int dev = 0, cus = 0, per_cu = 0;
        hipGetDevice(&dev); hipDeviceGetAttribute(&cus, hipDeviceAttributeMultiprocessorCount, dev);
        if (hipFuncSetAttribute((const void*)fwd_megakernel, hipFuncAttributeMaxDynamicSharedMemorySize, LDS_BYTES) != hipSuccess) { fprintf(stderr, "kernel_launch: hipFuncSetAttribute failed\n"); grid = -1; return; }
        if (hipOccupancyMaxActiveBlocksPerMultiprocessor(&per_cu, (const void*)fwd_megakernel, 512, LDS_BYTES) != hipSuccess || per_cu < 1) { fprintf(stderr, "kernel_launch: occupancy query says %d\n", per_cu); per_cu = 1; }
        (void)hipGetLastError();
        grid = cus;
    }
    if (grid < 0) return;
    if (hipMemsetAsync(d_ws, 0, CTL_ZERO_BYTES, stream) != hipSuccess) { fprintf(stderr, "kernel_launch: hipMemsetAsync failed\n"); return; }
    Args a{};
    for (int i = 0; i < 25; ++i) a.in[i] = (const float*)d_in[i];
    a.out = (float*)d_out; a.ws = (unsigned char*)d_ws; a.ph_lo = 0; a.ph_hi = N_PHASES;
    void* args[] = {&a};
    hipError_t e = hipLaunchCooperativeKernel((const void*)fwd_megakernel, dim3(grid), dim3(512), args, LDS_BYTES, stream);
    if (e != hipSuccess) fprintf(stderr, "cooperative launch failed: %s (grid %d)\n", hipGetErrorString(e), grid);
}
```

```cpp
#include <hip/hip_runtime.h>
#include <hip/hip_cooperative_groups.h>
#include <cstdio>
#include <cstdint>
namespace cg = cooperative_groups;
namespace pg8 {
#define PG8_LAS __attribute__((address_space(3)))
typedef unsigned short bf16_t;
typedef short bf16x8 __attribute__((ext_vector_type(8)));
typedef float f32x4 __attribute__((ext_vector_type(4)));
typedef unsigned u32x4 __attribute__((ext_vector_type(4)));
constexpr int BM = 256, BK = 64, HALF = 128, HTB = HALF * BK * 2  , STAGE_BYTES = 8 * HTB, NXCD = 8, WGM = 8;

__host__ __device__ __forceinline__ int lds_byte(int r, int c) { const int st = (r >> 4) * 2 + (c >> 5), rr = r & 15, cc = c & 31, ob = rr * 64 + cc * 2; return st * 1024 + (ob ^ (((ob >> 9) & 1) << 5)); }
__host__ __device__ __forceinline__ void stage_rc(int b, int& R, int& C) { const int st = b / 1024, sb = b % 1024, swz = sb ^ (((sb >> 9) & 1) << 5); R = (st >> 1) * 16 + swz / 64; C = (st & 1) * 32 + (swz % 64) / 2; }
__host__ __device__ __forceinline__ int perm32(int rho) { const int n = rho >> 4, i = rho & 15; return 8 * (i >> 2) + 4 * n + (i & 3); }

struct Unit { int pm, pn; };
struct Gemm { const bf16_t* A; const bf16_t* Bt; int M, N, K; };

struct StaticOrder {
    int nM, nN, nwg, G, c;
    __host__ __device__ void init(int M, int N, int G_, int c_) { nM = M / BM; nN = N / BM; nwg = nM * nN; G = G_; c = c_; }
    __host__ __device__ bool next(int i, Unit& u) const {
        const long L = (long)i * G + c; if (L >= nwg) return false;
        int wgid = (int)L; { const int q = nwg / NXCD, r = nwg % NXCD, xcd = wgid % NXCD, off = wgid / NXCD; wgid = (xcd < r ? xcd * (q + 1) : r * (q + 1) + (xcd - r) * q) + off; }
        const int nig = WGM * nN, gid = wgid / nig, fm = gid * WGM, gsz = (nM - fm) < WGM ? (nM - fm) : WGM;
        u.pm = fm + ((wgid % nig) % gsz); u.pn = (wgid % nig) / gsz; return true;
    }
    __device__ __forceinline__ void a_ready(const Unit&) const {}
    __device__ __forceinline__ void done(const Unit&) const {}
};

__device__ __forceinline__ unsigned cvt_pk_bf16(float lo, float hi) { unsigned r; asm volatile("v_cvt_pk_bf16_f32 %0, %1, %2" : "=v"(r) : "v"(lo), "v"(hi)); return r; }
typedef float f32x2 __attribute__((ext_vector_type(2)));
__device__ __forceinline__ f32x2 gelu_pk(f32x2 v) {
    const f32x2 av = __builtin_elementwise_abs(v), d = av * 0.2316418882f + 1.0f;
    f32x2 t; t.x = __builtin_amdgcn_rcpf(d.x); t.y = __builtin_amdgcn_rcpf(d.y);
    f32x2 q = t * 0.5307027145f + (-0.7265760135f); q = q * t + 0.7107068705f; q = q * t + (-0.142248368f); q = q * t + 0.127414796f; q = q * t;
    const f32x2 s = (v * v) * (-0.72134752044f);
    f32x2 e; e.x = __builtin_amdgcn_exp2f(s.x); e.y = __builtin_amdgcn_exp2f(s.y);
    const f32x2 m = v * (q * e), r = v - m;
    f32x2 o; o.x = v.x < 0.f ? m.x : r.x; o.y = v.y < 0.f ? m.y : r.y; return o;
}

template <int ACT  > struct EpiBf16 {
    static constexpr bool PERM = true, AFTER_DRAIN = false; static_assert(ACT == 0 || ACT == 1, "EpiBf16: ACT is 0 (none) or 1 (gelu_pk)");
    bf16_t* O; int ldc; const float* bias; int split_cols; size_t split_stride; float scale0;
    __device__ __forceinline__ void operator()(const f32x4 (&acc)[2][2][4][2], const Unit& u, int wr, int wc, int fr, int fq) const {
        const int row0 = u.pm * BM + wr * 64 + fr; int colt = u.pn * BM; bf16_t* base = O;
        float sc = 1.f; if (split_cols) { const int t = colt / split_cols; base += (size_t)t * split_stride; colt -= t * split_cols; if (t == 0) sc = scale0; }
        const int col0 = colt + wc * 32 + 8 * fq, bcol0 = u.pn * BM + wc * 32 + 8 * fq;
        f32x4 bv[2][2];
#pragma unroll
        for (int bj = 0; bj < 2; ++bj)
#pragma unroll
            for (int n = 0; n < 2; ++n) bv[bj][n] = bias ? *(const f32x4*)(bias + bcol0 + bj * HALF + 4 * n) : (f32x4){0.f, 0.f, 0.f, 0.f};
#pragma unroll
        for (int ai = 0; ai < 2; ++ai)
#pragma unroll
            for (int m = 0; m < 4; ++m) { bf16_t* rowp = base + (size_t)(row0 + ai * HALF + m * 16) * ldc + col0;
#pragma unroll
                for (int bj = 0; bj < 2; ++bj) { f32x4 v0 = acc[ai][bj][m][0] + bv[bj][0], v1 = acc[ai][bj][m][1] + bv[bj][1];
                    if (ACT == 1) { f32x2 a = gelu_pk((f32x2){v0[0], v0[1]}), b = gelu_pk((f32x2){v0[2], v0[3]}), c = gelu_pk((f32x2){v1[0], v1[1]}), d = gelu_pk((f32x2){v1[2], v1[3]});
                        v0 = (f32x4){a.x, a.y, b.x, b.y}; v1 = (f32x4){c.x, c.y, d.x, d.y}; }
                    v0 = v0 * sc; v1 = v1 * sc; u32x4 w; w.x = cvt_pk_bf16(v0[0], v0[1]); w.y = cvt_pk_bf16(v0[2], v0[3]); w.z = cvt_pk_bf16(v1[0], v1[1]); w.w = cvt_pk_bf16(v1[2], v1[3]);
                    *(u32x4*)(rowp + bj * HALF) = w; } }
    }
};
typedef __bf16 bf2_t __attribute__((ext_vector_type(2)));
typedef float f2_t __attribute__((ext_vector_type(2)));
__device__ __forceinline__ unsigned pkbf(float lo, float hi) { f2_t v = {lo, hi}; return __builtin_bit_cast(unsigned, __builtin_convertvector(v, bf2_t)); }
__device__ __forceinline__ float bflo(unsigned w) { return __uint_as_float(w << 16); }
__device__ __forceinline__ float bfhi(unsigned w) { return __uint_as_float(w & 0xffff0000u); }
__device__ __forceinline__ float fsigmoid(float g) { return __builtin_amdgcn_rcpf(1.0f + __builtin_amdgcn_exp2f(-1.44269504f * g)); }

struct EpiRowScale {
    static constexpr bool PERM = true, AFTER_DRAIN = false;
    bf16_t* O; int ldc; const float* ss; float invk, eps;
    __device__ __forceinline__ void operator()(const f32x4 (&acc)[2][2][4][2], const Unit& u, int wr, int wc, int fr, int fq) const {
        const int row0 = u.pm * BM + wr * 64 + fr, col0 = u.pn * BM + wc * 32 + 8 * fq;
#pragma unroll
        for (int ai = 0; ai < 2; ++ai)
#pragma unroll
            for (int m = 0; m < 4; ++m) { const int row = row0 + ai * HALF + m * 16; const float sc = rsqrtf(ss[row] * invk + eps); bf16_t* rowp = O + (size_t)row * ldc + col0;
#pragma unroll
                for (int bj = 0; bj < 2; ++bj) { const f32x4 v0 = acc[ai][bj][m][0] * sc, v1 = acc[ai][bj][m][1] * sc;
                    u32x4 w; w.x = pkbf(v0[0], v0[1]); w.y = pkbf(v0[2], v0[3]); w.z = pkbf(v1[0], v1[1]); w.w = pkbf(v1[2], v1[3]);
                    *(u32x4*)(rowp + bj * HALF) = w; } }
    }
};

struct EpiG1 {
    static constexpr bool PERM = true, AFTER_DRAIN = false;
    bf16_t* ub; bf16_t* gbb; bf16_t* Aq; bf16_t* zs; float* ssq; const float* ss; float invk, eps;
    __device__ __forceinline__ void operator()(const f32x4 (&acc)[2][2][4][2], const Unit& u, int wr, int wc, int fr, int fq) const {
        const int row0 = u.pm * BM + wr * 64 + fr, pn = u.pn, cw = wc * 32 + 8 * fq;
#pragma unroll
        for (int ai = 0; ai < 2; ++ai)
#pragma unroll
            for (int m = 0; m < 4; ++m) { const int row = row0 + ai * HALF + m * 16; const float sc = rsqrtf(ss[row] * invk + eps);
                if (pn < 4) { float h[8];
#pragma unroll
                    for (int n = 0; n < 2; ++n)
#pragma unroll
                        for (int j = 0; j < 4; ++j) h[4 * n + j] = (acc[ai][0][m][n][j] * sc) * (acc[ai][1][m][n][j] * sc);
                    u32x4 w; w.x = pkbf(h[0], h[1]); w.y = pkbf(h[2], h[3]); w.z = pkbf(h[4], h[5]); w.w = pkbf(h[6], h[7]);
                    *(u32x4*)(ub + (size_t)row * 512 + pn * HALF + cw) = w;
                } else { float ssum = 0.f;
#pragma unroll
                    for (int bj = 0; bj < 2; ++bj) { const f32x4 v0 = acc[ai][bj][m][0] * sc, v1 = acc[ai][bj][m][1] * sc;
                        u32x4 w; w.x = pkbf(v0[0], v0[1]); w.y = pkbf(v0[2], v0[3]); w.z = pkbf(v1[0], v1[1]); w.w = pkbf(v1[2], v1[3]);
                        const int c = bj * HALF + cw;
                        if (pn < 6) *(u32x4*)(gbb + (size_t)row * 512 + (pn - 4) * BM + c) = w;
                        else if (pn < 9) { *(u32x4*)(Aq + (size_t)row * 768 + (pn - 6) * BM + c) = w;
                            const float a0 = bflo(w.x), a1 = bfhi(w.x), a2 = bflo(w.y), a3 = bfhi(w.y), a4 = bflo(w.z), a5 = bfhi(w.z), a6 = bflo(w.w), a7 = bfhi(w.w);
                            ssum += (a0 * a0 + a1 * a1) + (a2 * a2 + a3 * a3) + (a4 * a4 + a5 * a5) + (a6 * a6 + a7 * a7); }
                        else if (pn == 9) *(u32x4*)(zs + (size_t)row * 320 + c) = w;
                        else if (c < 32) *(u32x4*)(zs + (size_t)row * 320 + 256 + c) = w; }
                    if (pn >= 6 && pn < 9) { ssum += __shfl_xor(ssum, 16); ssum += __shfl_xor(ssum, 32); if (fq == 0) atomicAdd(ssq + row, ssum); } } }
    }
};
struct EpiSwiGLU {
    static constexpr bool PERM = true, AFTER_DRAIN = false;
    bf16_t* O; int ldc; const float* ss; float invk, eps;
    __device__ __forceinline__ void operator()(const f32x4 (&acc)[2][2][4][2], const Unit& u, int wr, int wc, int fr, int fq) const {
        const int row0 = u.pm * BM + wr * 64 + fr, col0 = u.pn * HALF + wc * 32 + 8 * fq;
#pragma unroll
        for (int ai = 0; ai < 2; ++ai)
#pragma unroll
            for (int m = 0; m < 4; ++m) { const int row = row0 + ai * HALF + m * 16; const float sc = rsqrtf(ss[row] * invk + eps);
                float h[8];
#pragma unroll
                for (int n = 0; n < 2; ++n)
#pragma unroll
                    for (int j = 0; j < 4; ++j) { const float g = acc[ai][0][m][n][j] * sc, up = acc[ai][1][m][n][j] * sc; h[4 * n + j] = g * fsigmoid(g) * up; }
                u32x4 w; w.x = pkbf(h[0], h[1]); w.y = pkbf(h[2], h[3]); w.z = pkbf(h[4], h[5]); w.w = pkbf(h[6], h[7]);
                *(u32x4*)(O + (size_t)row * ldc + col0) = w; }
    }
};
struct EpiPle {
    static constexpr bool PERM = true, AFTER_DRAIN = false;
    const bf16_t* xin; const bf16_t* pp; bf16_t* xbn; float* Y; float* ssn; int last;
    __device__ __forceinline__ void operator()(const f32x4 (&acc)[2][2][4][2], const Unit& u, int wr, int wc, int fr, int fq) const {
        const int row0 = u.pm * BM + wr * 64 + fr, col0 = u.pn * BM + wc * 32 + 8 * fq;
#pragma unroll
        for (int ai = 0; ai < 2; ++ai)
#pragma unroll
            for (int m = 0; m < 4; ++m) { const int row = row0 + ai * HALF + m * 16; float ssum = 0.f;
#pragma unroll
                for (int bj = 0; bj < 2; ++bj) { const size_t off = (size_t)row * 1024 + col0 + bj * HALF;
                    const u32x4 xw = *(const u32x4*)(xin + off); const u32x4 pw = *(const u32x4*)(pp + off);
                    f32x4 x0 = {bflo(xw.x), bfhi(xw.x), bflo(xw.y), bfhi(xw.y)}, x1 = {bflo(xw.z), bfhi(xw.z), bflo(xw.w), bfhi(xw.w)};
                    const f32x4 p0 = {bflo(pw.x), bfhi(pw.x), bflo(pw.y), bfhi(pw.y)}, p1 = {bflo(pw.z), bfhi(pw.z), bflo(pw.w), bfhi(pw.w)};
                    const f32x4 g0 = acc[ai][bj][m][0], g1 = acc[ai][bj][m][1];
#pragma unroll
                    for (int j = 0; j < 4; ++j) { x0[j] += fsigmoid(g0[j]) * p0[j]; x1[j] += fsigmoid(g1[j]) * p1[j]; }
                    if (last) { *(f32x4*)(Y + off) = x0; *(f32x4*)(Y + off + 4) = x1; }
                    else { u32x4 w; w.x = pkbf(x0[0], x0[1]); w.y = pkbf(x0[2], x0[3]); w.z = pkbf(x1[0], x1[1]); w.w = pkbf(x1[2], x1[3]); *(u32x4*)(xbn + off) = w;
                        ssum += (x0[0] * x0[0] + x0[1] * x0[1]) + (x0[2] * x0[2] + x0[3] * x0[3]) + (x1[0] * x1[0] + x1[1] * x1[1]) + (x1[2] * x1[2] + x1[3] * x1[3]); } }
                if (!last) { ssum += __shfl_xor(ssum, 16); ssum += __shfl_xor(ssum, 32); if (fq == 0) atomicAdd(ssn + row, ssum); } }
    }
};
struct EpiQRope {
    static constexpr bool PERM = false, AFTER_DRAIN = false;
    bf16_t* O; const f2_t* tab; float qscale; const float* ssq;
    __device__ __forceinline__ void operator()(const f32x4 (&acc)[2][2][4][2], const Unit& u, int wr, int wc, int fr, int fq) const {
        typedef unsigned u32x2 __attribute__((ext_vector_type(2)));
        const int row0 = u.pm * BM + wr * 64 + fr;
#pragma unroll
        for (int ai = 0; ai < 2; ++ai)
#pragma unroll
            for (int m = 0; m < 4; ++m) { const int row = row0 + ai * HALF + m * 16; const int pos = row < 65536 ? (row & 2047) : 4096 + ((row - 65536) & 31);
#pragma unroll
                for (int bj = 0; bj < 2; ++bj) { const int c0 = u.pn * BM + bj * HALF + wc * 32; f32x4 a = acc[ai][bj][m][0], b = acc[ai][bj][m][1];
                    if ((c0 % 96) == 64) {
#pragma unroll
                        for (int j = 0; j < 4; ++j) { const f2_t cs = tab[pos * 16 + 4 * fq + j]; const float x1 = a[j], x2 = b[j]; a[j] = x1 * cs.x - x2 * cs.y; b[j] = x1 * cs.y + x2 * cs.x; } }
                    { const float qs = qscale * rsqrtf(ssq[row] * (1.0f / 768.0f) + 1e-6f); a = a * qs; b = b * qs; }
                    bf16_t* p = O + (size_t)row * 768 + c0 + 4 * fq;
                    u32x2 wa, wb; wa.x = pkbf(a[0], a[1]); wa.y = pkbf(a[2], a[3]); wb.x = pkbf(b[0], b[1]); wb.y = pkbf(b[2], b[3]);
                    *(u32x2*)p = wa; *(u32x2*)(p + 16) = wb; } }
    }
};

__host__ __device__ __forceinline__ int pi5(int k) { return (k & 0x13) | ((k & 4) << 1) | ((k & 8) >> 1); }
__host__ __device__ __forceinline__ size_t kf_off(int row, int h, int d0) { return ((((size_t)(row >> 5) * 8 + h) * 4 + (d0 >> 4)) * 64 + ((d0 >> 3) & 1) * 32 + pi5(row & 31)) * 8; }
__host__ __device__ __forceinline__ size_t vf_off(int h, int d, int kv0) { return (((((size_t)(kv0 >> 5) * 8 + h) * 2 + (d >> 5)) * 2 + ((kv0 >> 4) & 1)) * 64 + ((kv0 >> 3) & 1) * 32 + (d & 31)) * 8; }
__host__ __device__ __forceinline__ size_t krf_off(int row, int i) { return ((((size_t)(row >> 5) * 2 + (i >> 4)) * 64 + ((i >> 3) & 1) * 32 + pi5(row & 31)) * 8) + (i & 7); }
struct EpiBf16M {
    static constexpr bool PERM = true, AFTER_DRAIN = false;
    bf16_t* O; int ldc; int mode;
    __device__ __forceinline__ void operator()(const f32x4 (&acc)[2][2][4][2], const Unit& u, int wr, int wc, int fr, int fq) const {
        const int row0 = u.pm * BM + wr * 64 + fr, col0 = u.pn * BM + wc * 32 + 8 * fq;
#pragma unroll
        for (int ai = 0; ai < 2; ++ai)
#pragma unroll
            for (int m = 0; m < 4; ++m) { const int row = row0 + ai * HALF + m * 16;
#pragma unroll
                for (int bj = 0; bj < 2; ++bj) { const int col = col0 + bj * HALF; const f32x4 v0 = acc[ai][bj][m][0], v1 = acc[ai][bj][m][1];
                    u32x4 w; w.x = pkbf(v0[0], v0[1]); w.y = pkbf(v0[2], v0[3]); w.z = pkbf(v1[0], v1[1]); w.w = pkbf(v1[2], v1[3]);
                    const size_t off = mode == 0 ? (size_t)row * ldc + col : (mode == 1 ? kf_off(row, col >> 6, col & 63) : vf_off(row >> 6, row & 63, col));
                    *(u32x4*)(O + off) = w; } }
    }
};
template <class Epi, class Sched, bool ALIGN_EPI = false, bool SP2 = false>
__device__ __forceinline__ void gemm_phase(PG8_LAS unsigned char* lds, const Gemm g, const Sched& S, const Epi& E) {
    int tid_ = threadIdx.x; asm volatile("" : "+v"(tid_));
    const int tid = tid_, wid = __builtin_amdgcn_readfirstlane(tid >> 6), lane = tid & 63, wr = wid >> 2, wc = wid & 3, fr = lane & 15, fq = lane >> 4;
    const int K = g.K, nt = K / BK;
    unsigned voffA[2], voffB[2];
#pragma unroll
    for (int i = 0; i < 2; ++i) { int R, C; stage_rc(tid * 16 + i * 8192, R, C); const int Rb = Epi::PERM ? ((R & ~31) + perm32(R & 31)) : R;
        voffA[i] = (unsigned)(R * K + C) * 2u; voffB[i] = (unsigned)(Rb * K + C) * 2u; }
    const size_t kstep = (size_t)(BK * 2);
    const size_t hstep = (size_t)HALF * K * 2;
    const size_t tstep = 2 * hstep;
    const unsigned ldsw = (unsigned)wid * 1024u;
    const int aoff = lds_byte(wr * 64 + fr, fq * 8), boff = lds_byte(wc * 32 + fr, fq * 8);
#define PG8_SA(b, h) (((b) * 2 + (h)) * HTB)
#define PG8_SB(b, h) ((4 + (b) * 2 + (h)) * HTB)
#define PG8_STAGE(bufoff, gbase, voff) do { _Pragma("unroll") for (int _i = 0; _i < 2; ++_i) \
        __builtin_amdgcn_global_load_lds((const unsigned*)((const char*)(gbase) + (voff)[_i]), (PG8_LAS unsigned*)(lds + (bufoff) + ldsw + _i * 8192), 16, 0, 0); } while (0)
#define PG8_LDA(dst, b, h) do { _Pragma("unroll") for (int m = 0; m < 4; ++m) _Pragma("unroll") for (int k = 0; k < 2; ++k) dst[m][k] = *(const PG8_LAS bf16x8*)(lds + PG8_SA(b, h) + aoff + m * 2048 + k * 1024); } while (0)
#define PG8_LDB(dst, b, h) do { _Pragma("unroll") for (int n = 0; n < 2; ++n) _Pragma("unroll") for (int k = 0; k < 2; ++k) dst[n][k] = *(const PG8_LAS bf16x8*)(lds + PG8_SB(b, h) + boff + n * 2048 + k * 1024); } while (0)
#define PG8_MMA(ai, bj, At, Bt) do { __builtin_amdgcn_s_setprio(1); _Pragma("unroll") for (int m = 0; m < 4; ++m) _Pragma("unroll") for (int n = 0; n < 2; ++n) _Pragma("unroll") for (int k = 0; k < 2; ++k) \
        acc[ai][bj][m][n] = __builtin_amdgcn_mfma_f32_16x16x32_bf16(Bt[n][k], At[m][k], acc[ai][bj][m][n], 0, 0, 0); __builtin_amdgcn_s_setprio(0); } while (0)
#define PG8_WAIT_V(n) asm volatile("s_waitcnt vmcnt(" #n ")" ::: "memory")
#define PG8_WAIT_L(n) asm volatile("s_waitcnt lgkmcnt(" #n ")" ::: "memory")
#define PG8_BAR __builtin_amdgcn_s_barrier()
#define PG8_SCHED __builtin_amdgcn_sched_barrier(0)
    Unit cur, nxt; int ui = 0;
    if (!S.next(0, cur)) return;
    f32x4 acc[2][2][4][2];
#pragma unroll
    for (int a = 0; a < 2; ++a)
#pragma unroll
        for (int b = 0; b < 2; ++b)
#pragma unroll
            for (int m = 0; m < 4; ++m)
#pragma unroll
                for (int n = 0; n < 2; ++n) acc[a][b][m][n] = (f32x4){0.f, 0.f, 0.f, 0.f};
    bf16x8 At[4][2], B0[2][2], B1[2][2];
    const char* cA = (const char*)g.A + (size_t)cur.pm * tstep; const char* cB = (const char*)g.Bt + (size_t)cur.pn * tstep;
    S.a_ready(cur);
    if constexpr (SP2) {
        PG8_STAGE(PG8_SB(0, 0), cB, voffB); PG8_STAGE(PG8_SB(0, 1), cB + hstep, voffB); PG8_STAGE(PG8_SA(0, 0), cA, voffA); PG8_STAGE(PG8_SA(0, 1), cA + hstep, voffA);
        if (wr == 1) PG8_BAR;
        PG8_WAIT_V(2); PG8_BAR;
        PG8_STAGE(PG8_SB(1, 0), cB + kstep, voffB); PG8_STAGE(PG8_SA(1, 0), cA + kstep, voffA); PG8_STAGE(PG8_SB(1, 1), cB + hstep + kstep, voffB);
        PG8_WAIT_V(6); PG8_BAR;
    } else {
        PG8_STAGE(PG8_SB(0, 0), cB, voffB); PG8_STAGE(PG8_SA(0, 0), cA, voffA); PG8_STAGE(PG8_SB(0, 1), cB + hstep, voffB); PG8_STAGE(PG8_SA(0, 1), cA + hstep, voffA);
        if (wr == 1) PG8_BAR;
        PG8_WAIT_V(4); PG8_BAR;
        PG8_STAGE(PG8_SB(1, 0), cB + kstep, voffB); PG8_STAGE(PG8_SA(1, 0), cA + kstep, voffA); PG8_STAGE(PG8_SB(1, 1), cB + hstep + kstep, voffB);
        PG8_WAIT_V(6); PG8_BAR;
    }
    for (;;) {
        const bool has_next = S.next(ui + 1, nxt);
        const char* nA = has_next ? (const char*)g.A + (size_t)nxt.pm * tstep : cA; const char* nB = has_next ? (const char*)g.Bt + (size_t)nxt.pn * tstep : cB;
        for (int t = 0; t < nt; t += 2) {
            const bool last = (t == nt - 2);
            const char* a1 = cA + (size_t)(t + 1) * kstep;
            const char* a2 = last ? nA : cA + (size_t)(t + 2) * kstep; const char* b2 = last ? nB : cB + (size_t)(t + 2) * kstep;
            const char* a3 = a2 + kstep; const char* b3 = b2 + kstep;
            if (last && has_next) S.a_ready(nxt);
            if constexpr (SP2) {
            PG8_LDB(B0, 0, 0); PG8_LDB(B1, 0, 1); PG8_SCHED; PG8_LDA(At, 0, 0); PG8_STAGE(PG8_SA(1, 1), a1 + hstep, voffA);
            PG8_WAIT_V(8); PG8_WAIT_L(0); PG8_BAR; PG8_MMA(0, 0, At, B0); PG8_MMA(0, 1, At, B1); PG8_BAR; PG8_SCHED;
            PG8_LDA(At, 0, 1); PG8_STAGE(PG8_SB(0, 0), b2, voffB); PG8_STAGE(PG8_SB(0, 1), b2 + hstep, voffB); PG8_STAGE(PG8_SA(0, 0), a2, voffA);
            PG8_WAIT_V(8); PG8_WAIT_L(0); PG8_BAR; PG8_MMA(1, 0, At, B0); PG8_MMA(1, 1, At, B1); PG8_BAR; PG8_SCHED;
            PG8_LDB(B0, 1, 0); PG8_LDB(B1, 1, 1); PG8_SCHED; PG8_LDA(At, 1, 0); PG8_STAGE(PG8_SA(0, 1), a2 + hstep, voffA);
            PG8_WAIT_V(8); PG8_WAIT_L(0); PG8_BAR; PG8_MMA(0, 0, At, B0); PG8_MMA(0, 1, At, B1); PG8_BAR; PG8_SCHED;
            PG8_LDA(At, 1, 1); PG8_STAGE(PG8_SB(1, 0), b3, voffB); PG8_STAGE(PG8_SB(1, 1), b3 + hstep, voffB); PG8_STAGE(PG8_SA(1, 0), a3, voffA);
            PG8_WAIT_V(8); PG8_WAIT_L(0); PG8_BAR; PG8_MMA(1, 0, At, B0); PG8_MMA(1, 1, At, B1); PG8_BAR; PG8_SCHED;
            } else {
            PG8_LDB(B0, 0, 0); PG8_SCHED; PG8_LDA(At, 0, 0); PG8_STAGE(PG8_SA(1, 1), a1 + hstep, voffA);
            PG8_WAIT_L(8); PG8_BAR; PG8_WAIT_L(0); PG8_MMA(0, 0, At, B0); PG8_BAR; PG8_SCHED;
            PG8_LDB(B1, 0, 1); PG8_STAGE(PG8_SB(0, 0), b2, voffB);
            PG8_BAR; PG8_WAIT_L(0); PG8_MMA(0, 1, At, B1); PG8_BAR;
            PG8_LDA(At, 0, 1); PG8_STAGE(PG8_SA(0, 0), a2, voffA);
            PG8_BAR; PG8_WAIT_L(0); PG8_MMA(1, 0, At, B0); PG8_BAR; PG8_SCHED;
            PG8_STAGE(PG8_SB(0, 1), b2 + hstep, voffB);
            PG8_WAIT_V(6); PG8_BAR; PG8_MMA(1, 1, At, B1); PG8_BAR;
            PG8_LDB(B0, 1, 0); PG8_SCHED; PG8_LDA(At, 1, 0); PG8_STAGE(PG8_SA(0, 1), a2 + hstep, voffA);
            PG8_WAIT_L(8); PG8_BAR; PG8_WAIT_L(0); PG8_MMA(0, 0, At, B0); PG8_BAR; PG8_SCHED;
            PG8_LDB(B1, 1, 1); PG8_STAGE(PG8_SB(1, 0), b3, voffB);
            PG8_BAR; PG8_WAIT_L(0); PG8_MMA(0, 1, At, B1); PG8_BAR;
            PG8_LDA(At, 1, 1); PG8_STAGE(PG8_SA(1, 0), a3, voffA);
            PG8_BAR; PG8_WAIT_L(0); PG8_MMA(1, 0, At, B0); PG8_BAR; PG8_SCHED;
            PG8_STAGE(PG8_SB(1, 1), b3 + hstep, voffB);
            PG8_WAIT_V(6); PG8_BAR; PG8_MMA(1, 1, At, B1); PG8_BAR;
            }
        }
        if constexpr (ALIGN_EPI) { if (wr == 0) PG8_BAR; }
        if constexpr (!Epi::AFTER_DRAIN) { E(acc, cur, wr, wc, fr, fq); S.done(cur); }
        if (!has_next) break;
#pragma unroll
        for (int a = 0; a < 2; ++a)
#pragma unroll
            for (int b = 0; b < 2; ++b)
#pragma unroll
                for (int m = 0; m < 4; ++m)
#pragma unroll
                    for (int n = 0; n < 2; ++n) acc[a][b][m][n] = (f32x4){0.f, 0.f, 0.f, 0.f};
        cur = nxt; cA = nA; cB = nB; ++ui;
        if constexpr (ALIGN_EPI) { if (wr == 1) PG8_BAR; }
    }
    PG8_WAIT_V(0);
    if constexpr (!ALIGN_EPI) { if (wr == 0) PG8_BAR; }
    PG8_BAR;
    if constexpr (Epi::AFTER_DRAIN) { E.fused(acc, cur, wr, wc, fr, fq, lds, wid, lane); S.done(cur); }
#undef PG8_SA
#undef PG8_SB
#undef PG8_STAGE
#undef PG8_LDA
#undef PG8_LDB
#undef PG8_MMA
#undef PG8_WAIT_V
#undef PG8_WAIT_L
#undef PG8_BAR
#undef PG8_SCHED
}
}
#define LAS __attribute__((address_space(3)))
typedef unsigned short bf16_t;
typedef short bf16x8 __attribute__((ext_vector_type(8)));
typedef float f32x4 __attribute__((ext_vector_type(4)));
typedef float f32x16 __attribute__((ext_vector_type(16)));
typedef unsigned u32x4 __attribute__((ext_vector_type(4)));
typedef unsigned u32x2 __attribute__((ext_vector_type(2)));
typedef float f2_t __attribute__((ext_vector_type(2)));
using pg8::pkbf; using pg8::bflo; using pg8::bfhi;

constexpr int NP = 65536, NS = 256, M = NP + NS;
constexpr int MKV = 65536 + 8 * 4128, MKVM = MKV - 256;
constexpr int DM = 1024, NZ = 2816, NZV = 2592, DFF = 2816, NPOS = 4128;
constexpr float EPS = 1e-6f;
constexpr float QSCALE = 0.10206207261596577f * 1.4426950408889634f;
constexpr size_t O_YP = 0, O_YS = 67108864, O_LATP = 67371008, O_KRP = 100925440, O_CVP = 105119744, O_LATS = 105185280, O_KRS = 105316352, O_CVS = 105332736, O_END = 105349120;
constexpr size_t MiB = 1u << 20;
constexpr size_t WS_TAB = 1 * MiB, WS_SSQ = 1 * MiB + 576 * 1024, WS_SSA = 2 * MiB, WS_SSB = 2 * MiB + 512 * 1024, WS_W = 3 * MiB;
constexpr size_t W_IN = 0, W_UQ = W_IN + (size_t)NZ * 1024 * 2, W_KV = W_UQ + (size_t)768 * 768 * 2, W_O = W_KV + (size_t)1024 * 256 * 2, W_GU = W_O + (size_t)1024 * 1024 * 2,
                 W_D = W_GU + (size_t)5632 * 1024 * 2, W_PP = W_D + (size_t)1024 * 2816 * 2, W_PG = W_PP + (size_t)1024 * 256 * 2, W_LAYER = W_PG + (size_t)1024 * 1024 * 2;
constexpr size_t ACT = (size_t)M * 1024 * 2;
constexpr size_t WS_XB0 = WS_W + 2 * W_LAYER, WS_A3 = WS_XB0 + ACT, WS_R1 = WS_A3 + ACT, R1_BYTES = (size_t)M * NZ * 2, WS_R2 = WS_R1 + R1_BYTES, R2_BYTES = 2 * ACT,
                 WS_AKV = WS_R2 + R2_BYTES, WS_KRB = WS_AKV + (size_t)MKV * 256 * 2, WS_PB = WS_KRB + (size_t)MKV * 32 * 2, WS_END = WS_PB + (size_t)M * 256 * 2;
static_assert(WS_END <= (size_t)1 << 30, "workspace map exceeds 1 GiB");
static_assert(2 * (size_t)MKV * 512 * 2 + ACT <= R1_BYTES, "R1 overlay");
static_assert(WS_XB0 % 256 == 0 && WS_R1 % 256 == 0 && WS_R2 % 256 == 0 && WS_AKV % 256 == 0 && WS_KRB % 256 == 0 && WS_PB % 256 == 0, "alignment");

struct Args { const float* in[25]; float* out; unsigned char* ws; int ph_lo, ph_hi, rep_mask, pad; };
typedef const __attribute__((address_space(4))) Args* ArgP;

__device__ __forceinline__ float wave_sum(float v) {
#pragma unroll
    for (int o = 1; o < 64; o <<= 1) v += __shfl_xor(v, o);
    return v;
}
__device__ __forceinline__ void unpack8(const u32x4 w, float (&f)[8]) { f[0] = bflo(w.x); f[1] = bfhi(w.x); f[2] = bflo(w.y); f[3] = bfhi(w.y); f[4] = bflo(w.z); f[5] = bfhi(w.z); f[6] = bflo(w.w); f[7] = bfhi(w.w); }
__device__ __forceinline__ u32x4 pack8(const float (&f)[8]) { u32x4 w; w.x = pkbf(f[0], f[1]); w.y = pkbf(f[2], f[3]); w.z = pkbf(f[4], f[5]); w.w = pkbf(f[6], f[7]); return w; }
__device__ __forceinline__ int row_pos(int r) { return r < NP ? (r & 2047) : 4096 + ((r - NP) & 31); }

__device__ __forceinline__ void tr_item(const float* W, int ldw, int srccol0, const float* g0, const float* g1, int gsplit, bf16_t* WT, int K, int k0, int dstrow0, LAS float* scr, int lane) {
    if (srccol0 >= 0) {
#pragma unroll 16
        for (int i = 0; i < 32; ++i) { const int kk = 2 * i + (lane >> 5), k = k0 + kk; float gv = 1.f; if (g0) gv = (k < gsplit) ? g0[k] : g1[k - gsplit];
            scr[kk * 33 + (lane & 31)] = W[(size_t)k * ldw + srccol0 + (lane & 31)] * gv; }
    } else {
#pragma unroll 8
        for (int i = 0; i < 32; ++i) { const int kk = 2 * i + (lane >> 5); scr[kk * 33 + (lane & 31)] = 0.f; }
    }
    asm volatile("s_waitcnt lgkmcnt(0)" ::: "memory");
    const int c = lane & 7;
#pragma unroll
    for (int j = 0; j < 4; ++j) { const int n = (lane >> 3) + 8 * j; const LAS float* s = scr + (8 * c) * 33 + n;
        u32x4 o; o.x = pkbf(s[0 * 33], s[1 * 33]); o.y = pkbf(s[2 * 33], s[3 * 33]); o.z = pkbf(s[4 * 33], s[5 * 33]); o.w = pkbf(s[6 * 33], s[7 * 33]);
        *(u32x4*)(WT + (size_t)(dstrow0 + n) * K + k0 + 8 * c) = o; }
    asm volatile("s_waitcnt lgkmcnt(0)" ::: "memory");
}

__device__ __forceinline__ void prologue(ArgP ap, LAS unsigned char* lds, int gw, int NGW, int wave, int lane) {
    LAS float* scr = (LAS float*)(lds + wave * 16384);
    unsigned char* ws = ap->ws;
    int off = 0;
    for (int mi = 0; mi < 16; ++mi) {
        const int l = mi >> 3, t = mi & 7;
        const float* W = nullptr; const float* W2 = nullptr; const float* g0 = nullptr; const float* g1 = nullptr; int K = 0, ldw = 0, Nd = 0, mode = 0, gsplit = 0; size_t wo = 0;
        switch (t) {
            case 0: W = ap->in[8] + (size_t)l * 1024 * NZV; K = 1024; ldw = NZV; Nd = NZ; mode = 3; g0 = ap->in[7] + l * 1024; g1 = g0; gsplit = 1024; wo = W_IN; break;
            case 1: W = ap->in[11] + (size_t)l * 768 * 768; K = 768; ldw = 768; Nd = 768; mode = 0; g0 = ap->in[10] + l * 768; g1 = g0; gsplit = 768; wo = W_UQ; break;
            case 2: W = ap->in[13] + (size_t)l * 256 * 1024; K = 256; ldw = 1024; Nd = 1024; mode = 1; wo = W_KV; break;
            case 3: W = ap->in[16] + (size_t)l * 1024 * 1024; K = 1024; ldw = 1024; Nd = 1024; mode = 0; g0 = ap->in[14] + l * 512; g1 = ap->in[15] + l * 512; gsplit = 512; wo = W_O; break;
            case 4: W = ap->in[19] + (size_t)l * 1024 * DFF; W2 = ap->in[20] + (size_t)l * 1024 * DFF; K = 1024; ldw = DFF; Nd = 5632; mode = 2; g0 = ap->in[18] + l * 1024; g1 = g0; gsplit = 1024; wo = W_GU; break;
            case 5: W = ap->in[21] + (size_t)l * DFF * 1024; K = DFF; ldw = 1024; Nd = 1024; mode = 0; wo = W_D; break;
            case 6: W = ap->in[23] + (size_t)l * 256 * 1024; K = 256; ldw = 1024; Nd = 1024; mode = 0; wo = W_PP; break;
            default: W = ap->in[24] + (size_t)l * 1024 * 1024; K = 1024; ldw = 1024; Nd = 1024; mode = 0; wo = W_PG; break;
        }
        bf16_t* WT = (bf16_t*)(ws + WS_W + (size_t)l * W_LAYER + wo);
        const int nkb = K / 64, nitems = nkb * (Nd / 32);
        int start = gw - (off % NGW); if (start < 0) start += NGW;
        for (int it = start; it < nitems; it += NGW) {
            const int nb = it / nkb, kb = it % nkb, n0 = nb * 32; const float* Ws = W; int sc = n0;
            if (mode == 0) { if (n0 >= ldw) sc = -1; }
            else if (mode == 1) { const int part = n0 >> 9, hd = n0 & 511; sc = (hd >> 6) * 128 + part * 64 + (hd & 63); }
            else if (mode == 3) { if (n0 < 1024) { const int t = n0 >> 8, j = n0 & 255; sc = (j < 128) ? 512 + 128 * t + j : 1024 + 128 * t + (j - 128); } else if (n0 < 1536) sc = n0 - 1024; else if (n0 >= ldw) sc = -1; }
            else { const int pn = n0 >> 8, j = n0 & 255; if (j >= 128) Ws = W2; sc = pn * 128 + (j & 127); }
            tr_item(Ws, ldw, sc, g0, g1, gsplit, WT, K, kb * 64, n0, scr, lane);
        }
        off += nitems;
    }
    if (gw == 0 && lane < 16) ((unsigned*)ws)[lane * 64] = 0u;
    f2_t* tab = (f2_t*)(ws + WS_TAB);
    for (int e = gw * 64 + lane; e < NPOS * 16; e += NGW * 64) { const int pos = e >> 4, i = e & 15; const float inv = powf(10000.0f, -(float)i * 0.0625f); const float ang = (float)pos * inv; float s, c; sincosf(ang, &s, &c); tab[e] = (f2_t){c, s}; }
    bf16_t* xb0 = (bf16_t*)(ws + WS_XB0); float* ssA = (float*)(ws + WS_SSA);
    f32x4 v[2][2][2], vn[2][2][2];
#define PX_LOAD(dst, rbase) do { _Pragma("unroll") for (int i = 0; i < 2; ++i) { int r_ = (rbase) + i * NGW; if (r_ >= M) r_ = gw; \
        const float* xr_ = r_ < NP ? ap->in[0] + (size_t)r_ * 1024 : ap->in[1] + (size_t)(r_ - NP) * 1024; \
        _Pragma("unroll") for (int q = 0; q < 2; ++q) { const int c8 = 8 * (lane + 64 * q); dst[i][q][0] = *(const f32x4*)(xr_ + c8); dst[i][q][1] = *(const f32x4*)(xr_ + c8 + 4); } } } while (0)
    PX_LOAD(v, gw);
    for (int r0 = gw; r0 < M; r0 += 2 * NGW) {
        PX_LOAD(vn, r0 + 2 * NGW);
#pragma unroll
        for (int i = 0; i < 2; ++i) { const int r = r0 + i * NGW; const bool ok = r < M; float ss = 0.f;
#pragma unroll
            for (int q = 0; q < 2; ++q) { const int c8 = 8 * (lane + 64 * q); const f32x4 v0 = v[i][q][0], v1 = v[i][q][1];
                ss += (v0[0] * v0[0] + v0[1] * v0[1]) + (v0[2] * v0[2] + v0[3] * v0[3]) + (v1[0] * v1[0] + v1[1] * v1[1]) + (v1[2] * v1[2] + v1[3] * v1[3]);
                u32x4 w; w.x = pkbf(v0[0], v0[1]); w.y = pkbf(v0[2], v0[3]); w.z = pkbf(v1[0], v1[1]); w.w = pkbf(v1[2], v1[3]); if (ok) *(u32x4*)(xb0 + (size_t)r * 1024 + c8) = w; }
            ss = wave_sum(ss); if (lane == 0 && ok) { ssA[r] = ss; ((float*)(ws + WS_SSQ))[r] = 0.f; } }
#pragma unroll
        for (int i = 0; i < 2; ++i)
#pragma unroll
            for (int q = 0; q < 2; ++q) { v[i][q][0] = vn[i][q][0]; v[i][q][1] = vn[i][q][1]; }
    }
#undef PX_LOAD
}

__device__ __forceinline__ void e1_pass(ArgP ap, int l, int gw, int NGW, int lane) {
    unsigned char* ws = ap->ws;
    const bf16_t* ub = (const bf16_t*)(ws + WS_R1); const bf16_t* gbb = ub + (size_t)M * 512; const bf16_t* zs = ub + (size_t)M * 1024; bf16_t* A3 = (bf16_t*)(ws + WS_A3);
    bf16_t* Akv = (bf16_t*)(ws + WS_AKV); bf16_t* krb = (bf16_t*)(ws + WS_KRB); bf16_t* pb = (bf16_t*)(ws + WS_PB);
    const f2_t* tab = (const f2_t*)(ws + WS_TAB);
    const float* wconv = ap->in[9] + (size_t)l * 3 * 512; const float* gkv = ap->in[12] + l * 256; float* out = ap->out;
    const int c8 = 8 * lane;
#define E1_LOAD(P, rr) do { int r_ = (rr); if (r_ >= M) r_ = gw; const bool isp_ = r_ < NP; const int t_ = isp_ ? (r_ & 2047) : ((r_ - NP) & 31); const int pos_ = isp_ ? t_ : 4096 + t_; \
        const bf16_t* zr_ = zs + (size_t)r_ * 320; const bf16_t* ur_ = ub + (size_t)r_ * 512; \
        P##gb = *(const u32x4*)(gbb + (size_t)r_ * 512 + c8); P##u2 = *(const u32x4*)(ur_ + c8); P##u1 = *(const u32x4*)(ur_ - (t_ >= 1 ? 512 : 0) + c8); P##u0 = *(const u32x4*)(ur_ - (t_ >= 2 ? 1024 : 0) + c8); \
        P##kv = *(const u32x2*)(zr_ + 4 * lane); const float* pr_ = isp_ ? ap->in[5] + ((size_t)l * NP + r_) * 256 : ap->in[6] + ((size_t)l * NS + (r_ - NP)) * 256; P##p = *(const f32x4*)(pr_ + 4 * lane); \
        P##k1 = zr_[256 + (lane & 15)]; P##k2 = zr_[272 + (lane & 15)]; P##cs = tab[pos_ * 16 + (lane & 15)]; } while (0)
    u32x4 w_gb, w_u2, w_u1, w_u0, n_gb, n_u2, n_u1, n_u0; u32x2 w_kv, n_kv; f32x4 w_p, n_p; bf16_t w_k1, w_k2, n_k1, n_k2; f2_t w_cs, n_cs;
    E1_LOAD(w_, gw);
    for (int r = gw; r < M; r += NGW) {
        E1_LOAD(n_, r + NGW);
        const bool isp = r < NP; const int b = isp ? (r >> 11) : ((r - NP) >> 5), t = isp ? (r & 2047) : ((r - NP) & 31), L = isp ? 2048 : 32;
        const int kvrow = isp ? r : NP + b * 4128 + 4096 + t;
        float gb[8], u0[8], u1[8], u2[8];
        unpack8(w_gb, gb); unpack8(w_u2, u2); unpack8(w_u1, u1); unpack8(w_u0, u0);
        if (t < 2) {
            if (isp) {
#pragma unroll
                for (int j = 0; j < 8; ++j) { u0[j] = 0.f; if (t < 1) u1[j] = 0.f; } }
            else { const float* st0 = ap->in[4] + ((size_t)(l * 8 + b) * 2 + t) * 512 + c8; const float* st1 = ap->in[4] + ((size_t)(l * 8 + b) * 2 + 1) * 512 + c8;
#pragma unroll
                for (int j = 0; j < 8; ++j) { u0[j] = st0[j]; if (t < 1) u1[j] = st1[j]; } } }
        float co[8]; float ss = 0.f;
#pragma unroll
        for (int j = 0; j < 8; ++j) { const float cv = u0[j] * wconv[c8 + j] + u1[j] * wconv[512 + c8 + j] + u2[j] * wconv[1024 + c8 + j]; co[j] = gb[j] * cv; ss += co[j] * co[j]; }
        ss = wave_sum(ss); { const float rs = rsqrtf(ss * (1.0f / 512.0f) + EPS);
#pragma unroll
            for (int j = 0; j < 8; ++j) co[j] *= rs; }
        *(u32x4*)(A3 + (size_t)r * 1024 + c8) = pack8(co);
        if (t >= L - 2) { float* d = out + (isp ? O_CVP + ((size_t)(l * 32 + b) * 2 + (t - (L - 2))) * 512 : O_CVS + ((size_t)(l * 8 + b) * 2 + (t - (L - 2))) * 512) + c8;
            *(f32x4*)d = (f32x4){u2[0], u2[1], u2[2], u2[3]}; *(f32x4*)(d + 4) = (f32x4){u2[4], u2[5], u2[6], u2[7]}; }
        { const u32x2 w = w_kv; float v[4] = {bflo(w.x), bfhi(w.x), bflo(w.y), bfhi(w.y)};
            float s2 = (v[0] * v[0] + v[1] * v[1]) + (v[2] * v[2] + v[3] * v[3]); s2 = wave_sum(s2); const float rs = rsqrtf(s2 * (1.0f / 256.0f) + EPS);
            const f32x4 g = *(const f32x4*)(gkv + 4 * lane); f32x4 c = {v[0] * rs * g[0], v[1] * rs * g[1], v[2] * rs * g[2], v[3] * rs * g[3]};
            float* d = out + (isp ? O_LATP + ((size_t)(l * 32 + b) * 2048 + t) * 256 : O_LATS + ((size_t)(l * 8 + b) * 32 + t) * 256) + 4 * lane; *(f32x4*)d = c;
            u32x2 o; o.x = pkbf(c[0], c[1]); o.y = pkbf(c[2], c[3]); *(u32x2*)(Akv + (size_t)kvrow * 256 + 4 * lane) = o; }
        if (lane < 16) { const float x1 = bflo((unsigned)w_k1), x2 = bflo((unsigned)w_k2); const f2_t cs = w_cs;
            const float o1 = x1 * cs.x - x2 * cs.y, o2 = x1 * cs.y + x2 * cs.x;
            float* d = out + (isp ? O_KRP + ((size_t)(l * 32 + b) * 2048 + t) * 32 : O_KRS + ((size_t)(l * 8 + b) * 32 + t) * 32); d[lane] = o1; d[lane + 16] = o2;
            krb[pg8::krf_off(kvrow, lane)] = (bf16_t)(pkbf(o1, 0.f) & 0xffffu); krb[pg8::krf_off(kvrow, 16 + lane)] = (bf16_t)(pkbf(o2, 0.f) & 0xffffu); }
        { const f32x4 v = w_p;
            u32x2 o; o.x = pkbf(v[0], v[1]); o.y = pkbf(v[2], v[3]); *(u32x2*)(pb + (size_t)r * 256 + 4 * lane) = o; }
        w_gb = n_gb; w_u2 = n_u2; w_u1 = n_u1; w_u0 = n_u0; w_kv = n_kv; w_p = n_p; w_k1 = n_k1; w_k2 = n_k2; w_cs = n_cs;
    }
#undef E1_LOAD
    for (int j0 = gw; j0 < 8 * 4096; j0 += 4 * NGW) {
        f32x4 v[4]; float kr[4];
#pragma unroll
        for (int i = 0; i < 4; ++i) { const int j = j0 + i * NGW, jc = j < 8 * 4096 ? j : j0; const int b = jc >> 12, jj = jc & 4095;
            v[i] = *(const f32x4*)(ap->in[2] + ((size_t)(l * 8 + b) * 4096 + jj) * 256 + 4 * lane); kr[i] = ap->in[3][((size_t)(l * 8 + b) * 4096 + jj) * 32 + (lane & 31)]; }
#pragma unroll
        for (int i = 0; i < 4; ++i) { const int j = j0 + i * NGW; if (j < 8 * 4096) { const int b = j >> 12, jj = j & 4095; const size_t kvrow = (size_t)NP + b * 4128 + jj;
            u32x2 o; o.x = pkbf(v[i][0], v[i][1]); o.y = pkbf(v[i][2], v[i][3]); *(u32x2*)(Akv + kvrow * 256 + 4 * lane) = o;
            if (lane < 32) krb[pg8::krf_off((int)kvrow, lane)] = (bf16_t)(pkbf(kr[i], 0.f) & 0xffffu); } }
    }
}

__device__ __forceinline__ void resnorm_pass(const float* xa, const float* xs, const bf16_t* xbin, const bf16_t* yb, const float* g, bf16_t* xb, float* ss_out, float* ss_zero, int gw, int NGW, int lane) {
    (void)xa; (void)xs;
    f32x4 gv[2][2];
#pragma unroll
    for (int q = 0; q < 2; ++q) { gv[q][0] = *(const f32x4*)(g + 8 * (lane + 64 * q)); gv[q][1] = *(const f32x4*)(g + 8 * (lane + 64 * q) + 4); }
    u32x4 yw[2][2], xw[2][2], yn[2][2], xn[2][2];
#define RN_LOAD(dy, dx, rbase) do { _Pragma("unroll") for (int i = 0; i < 2; ++i) { int r_ = (rbase) + i * NGW; if (r_ >= M) r_ = (rbase) < M ? (rbase) : gw; \
        _Pragma("unroll") for (int q = 0; q < 2; ++q) { const int c8 = 8 * (lane + 64 * q); dy[i][q] = *(const u32x4*)(yb + (size_t)r_ * 1024 + c8); dx[i][q] = *(const u32x4*)(xbin + (size_t)r_ * 1024 + c8); } } } while (0)
    RN_LOAD(yw, xw, gw);
    for (int r0 = gw; r0 < M; r0 += 2 * NGW) {
        RN_LOAD(yn, xn, r0 + 2 * NGW);
#pragma unroll
        for (int i = 0; i < 2; ++i) { const int r = r0 + i * NGW; const bool ok = r < M; float y[2][8], x[2][8]; float s2 = 0.f;
#pragma unroll
            for (int q = 0; q < 2; ++q) { unpack8(yw[i][q], y[q]); unpack8(xw[i][q], x[q]);
#pragma unroll
                for (int j = 0; j < 8; ++j) s2 += y[q][j] * y[q][j]; }
            s2 = wave_sum(s2); const float rs = rsqrtf(s2 * (1.0f / 1024.0f) + EPS); float s3 = 0.f;
#pragma unroll
            for (int q = 0; q < 2; ++q) { float o[8];
#pragma unroll
                for (int j = 0; j < 4; ++j) { o[j] = x[q][j] + y[q][j] * rs * gv[q][0][j]; o[4 + j] = x[q][4 + j] + y[q][4 + j] * rs * gv[q][1][j]; }
                const u32x4 w = pack8(o);
                if (ss_out) { float ob[8]; unpack8(w, ob);
#pragma unroll
                    for (int j = 0; j < 8; ++j) s3 += ob[j] * ob[j]; }
                if (ok) *(u32x4*)(xb + (size_t)r * 1024 + 8 * (lane + 64 * q)) = w; }
            if (ss_out) s3 = wave_sum(s3);
            if (lane == 0 && ok) { if (ss_out) ss_out[r] = s3; if (ss_zero) ss_zero[r] = 0.f; } }
#pragma unroll
        for (int i = 0; i < 2; ++i)
#pragma unroll
            for (int q = 0; q < 2; ++q) { yw[i][q] = yn[i][q]; xw[i][q] = xn[i][q]; }
    }
#undef RN_LOAD
}

#define MFMA32(a, b, c) __builtin_amdgcn_mfma_f32_32x32x16_bf16((a), (b), (c), 0, 0, 0)
__device__ __forceinline__ void swap32(float x, float& a, float& b) { auto r = __builtin_amdgcn_permlane32_swap(__float_as_uint(x), __float_as_uint(x), false, false); a = __uint_as_float(r[0]); b = __uint_as_float(r[1]); }
__device__ __forceinline__ float max_x32(float x) { float a, b; swap32(x, a, b); return fmaxf(a, b); }
__device__ __forceinline__ float sum_x32(float x) { float a, b; swap32(x, a, b); return a + b; }
template <int NQB>
__device__ __forceinline__ void attn_unit(const bf16_t* __restrict__ Q, const bf16_t* __restrict__ Kn, const bf16_t* __restrict__ Kr, const bf16_t* __restrict__ VT, bf16_t* A3,
                                          int qrow0, int kvrow0, int nkb, int h, int lane, LAS float* red) {
    const int r = lane & 31, hh = lane >> 5;
    LAS bf16x8* qlds = (LAS bf16x8*)((LAS unsigned char*)red + 4096 + h * 12288) + lane;
#pragma unroll
    for (int qb = 0; qb < NQB; ++qb)
#pragma unroll
        for (int s = 0; s < 6; ++s) qlds[(qb * 6 + s) * 64] = *(const bf16x8*)(Q + (size_t)(qrow0 + 32 * qb + r) * 768 + h * 96 + 16 * s + 8 * hh);
    f32x16 O[NQB][2]; float mrun[NQB], lrun[NQB];
#pragma unroll
    for (int qb = 0; qb < NQB; ++qb) { mrun[qb] = -1e30f; lrun[qb] = 0.f;
#pragma unroll
        for (int db = 0; db < 2; ++db)
#pragma unroll
            for (int i = 0; i < 16; ++i) O[qb][db][i] = 0.f; }
    const int pr = (r & 0x13) | ((r & 4) << 1) | ((r & 8) >> 1);
    const int blk0 = kvrow0 >> 5; (void)pr;
    const bf16_t* kp = Kn + ((size_t)(blk0 * 8 + h) * 256 + lane) * 8;
    const bf16_t* krp = Kr + ((size_t)blk0 * 128 + lane) * 8;
    const bf16_t* vp = VT + ((size_t)(blk0 * 8 + h) * 256 + lane) * 8;
    bf16x8 Kf[6];
#pragma unroll
    for (int s = 0; s < 4; ++s) Kf[s] = *(const bf16x8*)(kp + 512 * s);
    Kf[4] = *(const bf16x8*)(krp); Kf[5] = *(const bf16x8*)(krp + 512);
    for (int kb = 0; kb < nkb; ++kb) {
        asm volatile("" ::: "memory");
        bf16x8 Vf[2][2];
#pragma unroll
        for (int db = 0; db < 2; ++db)
#pragma unroll
            for (int s2 = 0; s2 < 2; ++s2) Vf[db][s2] = *(const bf16x8*)(vp + (size_t)kb * 16384 + (db * 2 + s2) * 512);
        bf16x8 Kx[6];
        { const int kn = (kb + 1 < nkb) ? kb + 1 : kb;
#pragma unroll
            for (int s = 0; s < 4; ++s) Kx[s] = *(const bf16x8*)(kp + (size_t)kn * 16384 + 512 * s);
            Kx[4] = *(const bf16x8*)(krp + (size_t)kn * 1024); Kx[5] = *(const bf16x8*)(krp + (size_t)kn * 1024 + 512); }
#pragma unroll
        for (int qb = 0; qb < NQB; ++qb) {
            f32x16 X;
#pragma unroll
            for (int i = 0; i < 16; ++i) X[i] = 0.f;
#pragma unroll
            for (int s = 0; s < 6; ++s) X = MFMA32(Kf[s], qlds[(qb * 6 + s) * 64], X);
            float mx = X[0];
#pragma unroll
            for (int i = 1; i < 16; ++i) mx = fmaxf(mx, X[i]);
            mx = max_x32(mx);
            const float mnew = fmaxf(mrun[qb], mx), alpha = __builtin_amdgcn_exp2f(mrun[qb] - mnew); mrun[qb] = mnew;
            float ps = 0.f;
#pragma unroll
            for (int i = 0; i < 16; ++i) { X[i] = __builtin_amdgcn_exp2f(X[i] - mnew); ps += X[i]; }
            lrun[qb] = lrun[qb] * alpha + ps;
#pragma unroll
            for (int db = 0; db < 2; ++db)
#pragma unroll
                for (int i = 0; i < 16; ++i) O[qb][db][i] *= alpha;
#pragma unroll
            for (int s2 = 0; s2 < 2; ++s2) { u32x4 pw; pw.x = pkbf(X[8 * s2], X[8 * s2 + 1]); pw.y = pkbf(X[8 * s2 + 2], X[8 * s2 + 3]); pw.z = pkbf(X[8 * s2 + 4], X[8 * s2 + 5]); pw.w = pkbf(X[8 * s2 + 6], X[8 * s2 + 7]);
                const bf16x8 xs = __builtin_bit_cast(bf16x8, pw);
#pragma unroll
                for (int db = 0; db < 2; ++db) O[qb][db] = MFMA32(Vf[db][s2], xs, O[qb][db]); }
        }
#pragma unroll
        for (int s = 0; s < 6; ++s) Kf[s] = Kx[s];
    }
#pragma unroll
    for (int qb = 0; qb < NQB; ++qb) { const float lt = sum_x32(lrun[qb]); const float inv = 1.0f / lt; float ss = 0.f;
#pragma unroll
        for (int db = 0; db < 2; ++db)
#pragma unroll
            for (int i = 0; i < 16; ++i) { O[qb][db][i] *= inv; ss += O[qb][db][i] * O[qb][db][i]; }
        ss = sum_x32(ss);
        if (hh == 0) red[h * 64 + qb * 32 + r] = ss; }
    __syncthreads();
#pragma unroll
    for (int qb = 0; qb < NQB; ++qb) { float tot = 0.f;
#pragma unroll
        for (int w = 0; w < 8; ++w) tot += red[w * 64 + qb * 32 + r];
        const float rs = rsqrtf(tot * (1.0f / 512.0f) + EPS);
        bf16_t* op = A3 + (size_t)(qrow0 + 32 * qb + r) * 1024 + 512 + h * 64 + 4 * hh;
#pragma unroll
        for (int db = 0; db < 2; ++db)
#pragma unroll
            for (int g = 0; g < 4; ++g) { u32x2 w; w.x = pkbf(O[qb][db][4 * g] * rs, O[qb][db][4 * g + 1] * rs); w.y = pkbf(O[qb][db][4 * g + 2] * rs, O[qb][db][4 * g + 3] * rs);
                *(u32x2*)(op + 32 * db + 8 * g) = w; } }
    __syncthreads();
}


#define MFMA32T(a, b, c) __builtin_amdgcn_mfma_f32_32x32x16_bf16((a), (b), (c), 0, 0, 0)
__device__ __forceinline__ int crow32(int i, int hh) { return (i & 3) + 8 * (i >> 2) + 4 * hh; }
template <bool DUAL, class F>
__device__ __forceinline__ void tail_tiles(const bf16_t* A, int lda, const bf16_t* Bt, const bf16_t* Bt2, int ldb, int K, int mt, int nt, int bid, int G, int wave, int lane, LAS float* red, const F& f, int boff = 0) {
    const int r = lane & 31, hh = lane >> 5; int b0 = bid - boff; if (b0 < 0) b0 += G;
    for (int t = b0; t < mt * nt; t += G) { const int mb = t / nt, nb = t % nt;
        const bf16_t* ap = A + (size_t)(mb * 32 + r) * lda + wave * 16 + 8 * hh; const int brow = f.brow(nb);
        const bf16_t* bp = Bt + (size_t)(brow + r) * ldb + wave * 16 + 8 * hh; const bf16_t* bp2 = DUAL ? Bt2 + (size_t)(brow + r) * ldb + wave * 16 + 8 * hh : bp;
        f32x16 acc, acc2;
#pragma unroll
        for (int i = 0; i < 16; ++i) { acc[i] = 0.f; acc2[i] = 0.f; }
#pragma unroll 8
        for (int k = 0; k < K; k += 128) { const bf16x8 av = *(const bf16x8*)(ap + k); acc = MFMA32T(av, *(const bf16x8*)(bp + k), acc); if (DUAL) acc2 = MFMA32T(av, *(const bf16x8*)(bp2 + k), acc2); }
#pragma unroll
        for (int i = 0; i < 16; ++i) { red[(wave * 16 + i) * 64 + lane] = acc[i]; if (DUAL) red[8192 + (wave * 16 + i) * 64 + lane] = acc2[i]; }
        __syncthreads();
#pragma unroll
        for (int ii = 0; ii < 2; ++ii) { const int i = 2 * wave + ii; float v = 0.f, v2 = 0.f;
#pragma unroll
            for (int w = 0; w < 8; ++w) { v += red[(w * 16 + i) * 64 + lane]; if (DUAL) v2 += red[8192 + (w * 16 + i) * 64 + lane]; }
            f(v, v2, mb * 32 + crow32(i, hh), nb * 32, r); }
        __syncthreads();
    }
}
__device__ __forceinline__ bf16_t f2bf1(float v) { return (bf16_t)(pkbf(v, 0.f) & 0xffffu); }
struct TPlain { bf16_t* O; size_t ldo; __device__ __forceinline__ int brow(int nb) const { return nb * 32; }
    __device__ __forceinline__ void operator()(float v, float, int row, int c0, int r) const { O[(size_t)row * ldo + c0 + r] = f2bf1(v); } };
struct TKF { bf16_t* O; __device__ __forceinline__ int brow(int nb) const { return nb * 32; }
    __device__ __forceinline__ void operator()(float v, float, int row, int c0, int r) const { const int col = c0 + r; O[pg8::kf_off(MKVM + row, col >> 6, col & 56) + (col & 7)] = f2bf1(v); } };
struct TVF { bf16_t* O; __device__ __forceinline__ int brow(int nb) const { return nb * 32; }
    __device__ __forceinline__ void operator()(float v, float, int row, int c0, int r) const { const int kv = MKVM + c0 + r; O[pg8::vf_off(row >> 6, row & 63, kv & ~7) + (kv & 7)] = f2bf1(v); } };
struct TU { bf16_t* ub; const float* ss; int row_base; __device__ __forceinline__ int brow(int nb) const { return (nb >> 2) * 256 + (nb & 3) * 32; }
    __device__ __forceinline__ void operator()(float v, float v2, int row, int c0, int r) const { row += row_base; const float sc = rsqrtf(ss[row] * (1.0f / 1024.0f) + EPS); ub[(size_t)row * 512 + c0 + r] = f2bf1((v * sc) * (v2 * sc)); } };
struct TG1b { bf16_t* gbb; bf16_t* Aq; bf16_t* zs; float* ssq; const float* ss; int row_base; __device__ __forceinline__ int brow(int nb) const { return 1024 + nb * 32; }
    __device__ __forceinline__ void operator()(float v, float, int row, int c0, int r) const { row += row_base; const float sc = rsqrtf(ss[row] * (1.0f / 1024.0f) + EPS); const bf16_t o = f2bf1(v * sc); const int nb = c0 >> 5;
        if (nb < 16) gbb[(size_t)row * 512 + c0 + r] = o;
        else if (nb < 40) { Aq[(size_t)row * 768 + (c0 - 512) + r] = o; const float a = bflo((unsigned)o); float q = a * a; q += __shfl_xor(q, 1); q += __shfl_xor(q, 2); q += __shfl_xor(q, 4); q += __shfl_xor(q, 8); q += __shfl_xor(q, 16); if (r == 0) atomicAdd(ssq + row, q); }
        else zs[(size_t)row * 320 + (c0 - 1280) + r] = o; } };
struct TRowScale { bf16_t* O; int ldo; const float* ss; int row_base; __device__ __forceinline__ int brow(int nb) const { return nb * 32; }
    __device__ __forceinline__ void operator()(float v, float, int row, int c0, int r) const { row += row_base; const float sc = rsqrtf(ss[row] * (1.0f / 1024.0f) + EPS); O[(size_t)row * ldo + c0 + r] = f2bf1(v * sc); } };
struct TQRope { bf16_t* O; const f2_t* tab; int row_base; const float* ssq; __device__ __forceinline__ int brow(int nb) const { return nb * 32; }
    __device__ __forceinline__ void operator()(float v, float, int row, int c0, int r) const { row += row_base;
        if ((c0 % 96) == 64) { const float o = __shfl_xor(v, 16); const f2_t cs = tab[row_pos(row) * 16 + (r & 15)]; v = (r < 16) ? (v * cs.x - o * cs.y) : (o * cs.y + v * cs.x); }
        O[(size_t)row * 768 + c0 + r] = f2bf1(v * QSCALE * rsqrtf(ssq[row] * (1.0f / 768.0f) + EPS)); } };
struct TSwiGLU { bf16_t* O; const float* ss; int row_base; __device__ __forceinline__ int brow(int nb) const { return (nb >> 2) * 256 + (nb & 3) * 32; }
    __device__ __forceinline__ void operator()(float v, float v2, int row, int c0, int r) const { row += row_base; const float sc = rsqrtf(ss[row] * (1.0f / 1024.0f) + EPS); const float g = v * sc, up = v2 * sc;
        O[(size_t)row * DFF + c0 + r] = f2bf1(g * pg8::fsigmoid(g) * up); } };
struct TPle { const bf16_t* xin; const bf16_t* pp; bf16_t* xbn; float* Y; float* ssn; int last; int row_base; __device__ __forceinline__ int brow(int nb) const { return nb * 32; }
    __device__ __forceinline__ void operator()(float v, float, int row, int c0, int r) const { row += row_base; const size_t off = (size_t)row * 1024 + c0 + r;
        const float x3 = bflo((unsigned)xin[off]) + pg8::fsigmoid(v) * bflo((unsigned)pp[off]);
        if (last) Y[off] = x3;
        else { xbn[off] = f2bf1(x3); float s = x3 * x3; s += __shfl_xor(s, 1); s += __shfl_xor(s, 2); s += __shfl_xor(s, 4); s += __shfl_xor(s, 8); s += __shfl_xor(s, 16); if (r == 0) atomicAdd(ssn + row, s); } } };

#define XB_TMO      128
#define XB_XCNT(j)  (256  + 64 * (j))
#define XB_XSUB(j)  (1280 + 64 * (j))
#define XB_XGEN(j)  (2304 + 64 * (j))
#define XB_TOP      3328
#define XB_TOPGEN   3392
#define XCD_BAR_WORDS 3456
#define XB_SPIN_CAP (1u << 18)

__device__ __forceinline__ unsigned xb_ld(unsigned* p)              { return __hip_atomic_load(p, __ATOMIC_RELAXED, __HIP_MEMORY_SCOPE_AGENT); }
__device__ __forceinline__ unsigned xb_add(unsigned* p, unsigned v) { return __hip_atomic_fetch_add(p, v, __ATOMIC_RELAXED, __HIP_MEMORY_SCOPE_AGENT); }
__device__ __forceinline__ unsigned xb_xcc_id() { return (unsigned)__builtin_amdgcn_s_getreg((3 << 11) | 20) & 0xFu; }
#define XB_SPIN(cond, bar) do { unsigned _sp = 0; while (cond) { __builtin_amdgcn_s_sleep(1); \
    if ((++_sp & 255u) == 0u) { if (xb_ld(&(bar)[XB_TMO])) break; if (_sp > XB_SPIN_CAP) { atomicAdd(&(bar)[XB_TMO], 1u); break; } } } } while (0)

struct XcdBarrier {
    unsigned* bar; unsigned x;
    volatile LAS unsigned* st;
};

__device__ __forceinline__ XcdBarrier xcd_barrier_post(unsigned* bar, volatile LAS unsigned* st) {
    XcdBarrier b; b.bar = bar; b.x = xb_xcc_id(); b.st = st;
    if (threadIdx.x == 0) (void)xb_add(&bar[XB_XCNT(b.x)], 1u);
    return b;
}
__device__ __forceinline__ void xcd_barrier_complete(unsigned* bar, unsigned x, unsigned& nloc, unsigned& nx) {
    const unsigned G = gridDim.x * gridDim.y * gridDim.z;
    unsigned sum, cnt, mine, sp = 0u;
    for (;;) {
        sum = 0u; cnt = 0u; mine = 0u;
#pragma unroll
        for (unsigned j = 0; j < 16; ++j) { const unsigned c = xb_ld(&bar[XB_XCNT(j)]); sum += c; cnt += (c > 0u) ? 1u : 0u; mine = (j == x) ? c : mine; }
        if (sum == G) break;
        __builtin_amdgcn_s_sleep(1);
        if ((++sp & 255u) == 0u) { if (xb_ld(&bar[XB_TMO])) break; if (sp > XB_SPIN_CAP) { atomicAdd(&bar[XB_TMO], 1u); break; } }
    }
    nloc = mine > 0u ? mine : 1u; nx = cnt > 0u ? cnt : 1u;
}

__device__ __forceinline__ void xcd_barrier(const XcdBarrier& b) {
    asm volatile("s_waitcnt vmcnt(0)" ::: "memory");
    __syncthreads();
    if (threadIdx.x == 0) {
        unsigned* bar = b.bar;
        __builtin_amdgcn_s_waitcnt(0);
        unsigned nloc = b.st[0], nx = b.st[1];
        if (nloc == 0u) { xcd_barrier_complete(bar, b.x, nloc, nx); b.st[0] = nloc; b.st[1] = nx; }
        const unsigned old = xb_add(&bar[XB_XSUB(b.x)], 1u);
        const unsigned gen = old / nloc;
        if (old + 1u == (gen + 1u) * nloc) {
            __builtin_amdgcn_fence(__ATOMIC_RELEASE, "agent");
            asm volatile("s_waitcnt vmcnt(0)" ::: "memory");
            const unsigned og = xb_add(&bar[XB_TOP], 1u);
            const unsigned tg = og / nx;
            if (og + 1u == (tg + 1u) * nx) xb_add(&bar[XB_TOPGEN], 1u);
            else XB_SPIN(xb_ld(&bar[XB_TOPGEN]) == tg, bar);
            __builtin_amdgcn_fence(__ATOMIC_ACQUIRE, "agent");
            xb_add(&bar[XB_XGEN(b.x)], 1u);
            asm volatile("s_waitcnt vmcnt(0)" ::: "memory");
        } else {
            XB_SPIN(xb_ld(&bar[XB_XGEN(b.x)]) == gen, bar);
            __builtin_amdgcn_fence(__ATOMIC_ACQUIRE, "agent");
            asm volatile("s_waitcnt vmcnt(0)" ::: "memory");
        }
    }
    __syncthreads();
}

constexpr int LDS_BYTES = 147456, XB_LDS_OFF = 140032, XB_WS_WORD = 4096, CTL_ZERO_BYTES = 65536;
constexpr int PH_PER_LAYER = 10, N_PHASES = 1 + 2 * PH_PER_LAYER;
__global__ void __launch_bounds__(512, 2) fwd_megakernel(Args a_) {
    extern __shared__ __attribute__((aligned(16))) unsigned char lds_raw[];
    cg::grid_group grid = cg::this_grid();
    LAS unsigned char* lds = (LAS unsigned char*)lds_raw;
    int ph_lo, ph_hi; XcdBarrier xbar;
    { ArgP ap0 = (ArgP)__builtin_amdgcn_kernarg_segment_ptr(); ph_lo = ap0->ph_lo; ph_hi = ap0->ph_hi;
      LAS unsigned* stw = (LAS unsigned*)(lds + XB_LDS_OFF); if (threadIdx.x < 2) stw[threadIdx.x] = 0u; __syncthreads();
      xbar = xcd_barrier_post((unsigned*)ap0->ws + XB_WS_WORD, (volatile LAS unsigned*)stw); }
    int rep_done = 0; (void)rep_done;
    for (int ph = ph_lo; ph < ph_hi; ++ph) {
        ArgP ap = (ArgP)__builtin_amdgcn_kernarg_segment_ptr(); asm volatile("" : "+s"(ap));
        int G = gridDim.x, bid = blockIdx.x; asm volatile("" : "+s"(G), "+s"(bid));
        int tid = threadIdx.x; asm volatile("" : "+v"(tid));
        const int lane = tid & 63, wave = __builtin_amdgcn_readfirstlane(tid >> 6);
        const int gw = bid * 8 + wave, NGW = G * 8;
        unsigned char* ws = ap->ws;
        float* Y = ap->out;
        bf16_t* xb1 = (bf16_t*)ap->out;
        float* ssA = (float*)(ws + WS_SSA); float* ssB = (float*)(ws + WS_SSB);
        bf16_t* xb0 = (bf16_t*)(ws + WS_XB0); bf16_t* A3 = (bf16_t*)(ws + WS_A3);
        bf16_t* R1 = (bf16_t*)(ws + WS_R1); bf16_t* R2 = (bf16_t*)(ws + WS_R2);
        bf16_t* Akv = (bf16_t*)(ws + WS_AKV); bf16_t* krb = (bf16_t*)(ws + WS_KRB); bf16_t* pb = (bf16_t*)(ws + WS_PB);
        bf16_t* Knb = R1; bf16_t* VTb = R1 + (size_t)MKV * 512; bf16_t* mixb = R1 + (size_t)2 * MKV * 512;
        bf16_t* Aq = R2; bf16_t* qbuf = R2 + (size_t)M * 768; bf16_t* fb = R2; bf16_t* ppb = R2 + (size_t)M * 1024;
        if (ph == 0) {
#ifndef OFF_P0
 prologue(ap, lds, gw, NGW, wave, lane);
#endif
 }
        else {
            const int l = (ph - 1) / PH_PER_LAYER, k = (ph - 1) % PH_PER_LAYER;
            const unsigned char* wl = ws + WS_W + (size_t)l * W_LAYER;
            int nplain = 0; pg8::Gemm gA{nullptr, nullptr, 0, 0, 0}, gB{nullptr, nullptr, 0, 0, 0}; bf16_t* oA = nullptr; bf16_t* oB = nullptr; int ldA = 0, ldB = 0, mdA = 0, mdB = 0;
            if (k == 0) {
                const bf16_t* xin_ = l == 0 ? xb0 : xb1; pg8::Gemm g{xin_, (const bf16_t*)(wl + W_IN), NP, NZ, 1024}; pg8::StaticOrder S; S.init(NP, NZ, G, bid);
                float* ssq = (float*)(ws + WS_SSQ); bf16_t* gbb = R1 + (size_t)M * 512; bf16_t* zsb = R1 + (size_t)M * 1024;
                pg8::EpiG1 E{R1, gbb, Aq, zsb, ssq, ssA, 1.0f / 1024.0f, EPS};

#ifndef OFF_G1
                pg8::gemm_phase<pg8::EpiG1, pg8::StaticOrder, true, true>(lds, g, S, E);
#endif
                { const TU T{R1, ssA, NP}; tail_tiles<true>(xin_ + (size_t)NP * 1024, 1024, (const bf16_t*)(wl + W_IN), (const bf16_t*)(wl + W_IN) + (size_t)128 * 1024, 1024, 1024, 8, 16, bid, G, wave, lane, (LAS float*)lds, T, 136 % G); }
                { const TG1b T{gbb, Aq, zsb, ssq, ssA, NP}; tail_tiles<false>(xin_ + (size_t)NP * 1024, 1024, (const bf16_t*)(wl + W_IN), nullptr, 1024, 1024, 8, 49, bid, G, wave, lane, (LAS float*)lds, T); }

            } else if (k == 1) {
#ifndef OFF_E1
 e1_pass(ap, l, gw, NGW, lane);
#endif

            } else if (k == 2) {
                pg8::Gemm g{Aq, (const bf16_t*)(wl + W_UQ), NP, 768, 768}; pg8::StaticOrder S; S.init(NP, 768, G, bid);
                pg8::EpiQRope E{qbuf, (const f2_t*)(ws + WS_TAB), QSCALE, (const float*)(ws + WS_SSQ)};

#ifndef OFF_G2
                pg8::gemm_phase<pg8::EpiQRope, pg8::StaticOrder, true, true>(lds, g, S, E);
#endif
                { const TQRope T{qbuf, (const f2_t*)(ws + WS_TAB), NP, (const float*)(ws + WS_SSQ)}; tail_tiles<false>(Aq + (size_t)NP * 768, 768, (const bf16_t*)(wl + W_UQ), nullptr, 768, 768, 8, 24, bid, G, wave, lane, (LAS float*)lds, T); }
                { const TKF T{Knb}; tail_tiles<false>(Akv + (size_t)MKVM * 256, 256, (const bf16_t*)(wl + W_KV), nullptr, 256, 256, 8, 16, bid, G, wave, lane, (LAS float*)lds, T, 192 % G); }
                { const TVF T{VTb}; tail_tiles<false>((const bf16_t*)(wl + W_KV) + (size_t)512 * 256, 256, Akv + (size_t)MKVM * 256, nullptr, 256, 256, 16, 8, bid, G, wave, lane, (LAS float*)lds, T, 64 % G); }

                nplain = 2;
                gA = pg8::Gemm{Akv, (const bf16_t*)(wl + W_KV), MKVM, 512, 256}; oA = Knb; ldA = 512; mdA = 1;
                gB = pg8::Gemm{(const bf16_t*)(wl + W_KV) + (size_t)512 * 256, Akv, 512, MKVM, 256}; oB = VTb; ldB = MKV; mdB = 2;
            } else if (k == 3) {
                LAS float* red = (LAS float*)lds;
                LAS int* slot = (LAS int*)(lds + 2048);
                for (int qi = 0; qi < 8; ++qi) { const int x = ((bid & 7) + qi) & 7; unsigned* ctr = (unsigned*)ws + (l * 8 + x) * 64;
                    for (;;) {
                        if (tid == 0) *slot = (int)__hip_atomic_fetch_add(ctr, 1u, __ATOMIC_RELAXED, __HIP_MEMORY_SCOPE_AGENT);
                        __syncthreads();
                        const int u = *slot;
                        __syncthreads();
                        if (u >= 129) break;
#ifndef OFF_ATT
                        if (u == 0) attn_unit<1>(qbuf, Knb, krb, VTb, A3, NP + x * 32, NP + x * 4128, 129, wave, lane, red);
                        else { const int i = u - 1, b = x + 8 * (i >> 5), c = 31 - (i & 31); attn_unit<2>(qbuf, Knb, krb, VTb, A3, b * 2048 + 64 * c, b * 2048, 2 * (c + 1), wave, lane, red); }
#endif
                    } }
            } else if (k == 4) {
                nplain = 2;
                gA = pg8::Gemm{A3, (const bf16_t*)(wl + W_O), NP, 1024, 1024}; oA = mixb; ldA = 1024;
                gB = pg8::Gemm{pb, (const bf16_t*)(wl + W_PP), NP, 1024, 256}; oB = ppb; ldB = 1024;
                { const TPlain T{mixb + (size_t)NP * 1024, 1024}; tail_tiles<false>(A3 + (size_t)NP * 1024, 1024, (const bf16_t*)(wl + W_O), nullptr, 1024, 1024, 8, 32, bid, G, wave, lane, (LAS float*)lds, T); }
                { const TPlain T{ppb + (size_t)NP * 1024, 1024}; tail_tiles<false>(pb + (size_t)NP * 256, 256, (const bf16_t*)(wl + W_PP), nullptr, 256, 256, 8, 32, bid, G, wave, lane, (LAS float*)lds, T); }
            } else if (k == 5) {
                resnorm_pass(nullptr, nullptr, l == 0 ? xb0 : xb1, mixb, ap->in[17] + l * 1024, xb0, ssB, (float*)(ws + WS_SSQ), gw, NGW, lane);
            } else if (k == 6) {
                pg8::Gemm g{xb0, (const bf16_t*)(wl + W_GU), NP, 5632, 1024}; pg8::StaticOrder S; S.init(NP, 5632, G, bid);
                pg8::EpiSwiGLU E{R1, DFF, ssB, 1.0f / 1024.0f, EPS};

#ifndef OFF_G4
                pg8::gemm_phase<pg8::EpiSwiGLU, pg8::StaticOrder, true, true>(lds, g, S, E);
#endif
                { const TSwiGLU T{R1, ssB, NP}; tail_tiles<true>(xb0 + (size_t)NP * 1024, 1024, (const bf16_t*)(wl + W_GU), (const bf16_t*)(wl + W_GU) + (size_t)128 * 1024, 1024, 1024, 8, DFF / 32, bid, G, wave, lane, (LAS float*)lds, T); }

            } else if (k == 7) {
                nplain = 1; gA = pg8::Gemm{R1, (const bf16_t*)(wl + W_D), NP, 1024, DFF}; oA = fb; ldA = 1024;
                { const TPlain T{fb + (size_t)NP * 1024, 1024}; tail_tiles<false>(R1 + (size_t)NP * DFF, DFF, (const bf16_t*)(wl + W_D), nullptr, DFF, DFF, 8, 32, bid, G, wave, lane, (LAS float*)lds, T); }
            } else if (k == 8) {
                resnorm_pass(nullptr, nullptr, xb0, fb, ap->in[22] + l * 1024, xb0, nullptr, ssA, gw, NGW, lane);
            } else {
                pg8::Gemm g{xb0, (const bf16_t*)(wl + W_PG), NP, 1024, 1024}; pg8::StaticOrder S; S.init(NP, 1024, G, bid);
                pg8::EpiPle E{xb0, ppb, xb1, Y, ssA, l == 1 ? 1 : 0};

#ifndef OFF_G6
                pg8::gemm_phase<pg8::EpiPle, pg8::StaticOrder, true, true>(lds, g, S, E);
#endif
                { const TPle T{xb0, ppb, xb1, Y, ssA, l == 1 ? 1 : 0, NP}; tail_tiles<false>(xb0 + (size_t)NP * 1024, 1024, (const bf16_t*)(wl + W_PG), nullptr, 1024, 1024, 8, 32, bid, G, wave, lane, (LAS float*)lds, T); }

            }
            for (int j = 0; j < nplain; ++j) {
                const pg8::Gemm g = j == 0 ? gA : gB; pg8::StaticOrder S; S.init(g.M, g.N, G, bid);
                pg8::EpiBf16M E{j == 0 ? oA : oB, j == 0 ? ldA : ldB, j == 0 ? mdA : mdB};

#ifndef OFF_GP
                pg8::gemm_phase<pg8::EpiBf16M, pg8::StaticOrder, true, true>(lds, g, S, E);
#endif

            }
        }
        if (ph + 1 < ph_hi) { if (ph_lo < 0) grid.sync(); else xcd_barrier(xbar); }
#ifdef REP_MASK
        if (ph >= 1) { const int kq = (ph - 1) % PH_PER_LAYER; if (!rep_done && ((REP_MASK >> kq) & 1)) { rep_done = 1; --ph; } else rep_done = 0; }
#endif
    }
}

extern "C" void kernel_launch(void* const* d_in, const int* in_sizes, int n_in, void* d_out, int out_size, void* d_ws, size_t ws_size, hipStream_t stream) {
    static int grid = 0;
    if (grid == 0) {
        if (n_in != 25 || (size_t)out_size != O_END || ws_size < WS_END) { fprintf(stderr, "kernel_launch: unexpected shapes: n_in %d out %d ws %zu (need %zu)\n", n_in, out_size, ws_size, (size_t)WS_END); grid = -1; return; }
        int dev = 0, cus = 0, per_cu = 0;
        hipGetDevice(&dev); hipDeviceGetAttribute(&cus, hipDeviceAttributeMultiprocessorCount, dev);
        if (hipFuncSetAttribute((const void*)fwd_megakernel, hipFuncAttributeMaxDynamicSharedMemorySize, LDS_BYTES) != hipSuccess) { fprintf(stderr, "kernel_launch: hipFuncSetAttribute failed\n"); grid = -1; return; }
        if (hipOccupancyMaxActiveBlocksPerMultiprocessor(&per_cu, (const void*)fwd_megakernel, 512, LDS_BYTES) != hipSuccess || per_cu < 1) { fprintf(stderr, "kernel_launch: occupancy query says %d\n", per_cu); per_cu = 1; }
        (void)hipGetLastError();
        grid = cus;
    }
    if (grid < 0) return;
    if (hipMemsetAsync(d_ws, 0, CTL_ZERO_BYTES, stream) != hipSuccess) { fprintf(stderr, "kernel_launch: hipMemsetAsync failed\n"); return; }
    Args a{};
    for (int i = 0; i < 25; ++i) a.in[i] = (const float*)d_in[i];
    a.out = (float*)d_out; a.ws = (unsigned char*)d_ws; a.ph_lo = 0; a.ph_hi = N_PHASES;
    void* args[] = {&a};
    hipError_t e = hipLaunchCooperativeKernel((const void*)fwd_megakernel, dim3(grid), dim3(512), args, LDS_BYTES, stream);
    if (e != hipSuccess) fprintf(stderr, "cooperative launch failed: %s (grid %d)\n", hipGetErrorString(e), grid);
}
```
